# Optimizing an MI355X kernel written in HIP

```python
import jax, jax.numpy as jnp
from jax import lax
import numpy as np

D_MODEL = 1024
BATCH = 16
SEQ = 2048
DEPTH = 1

RET_HEADS = 4
RET_QK_DIM = D_MODEL // RET_HEADS
RET_V_DIM = 2 * RET_QK_DIM
RET_QK = RET_HEADS * RET_QK_DIM
RET_V = RET_HEADS * RET_V_DIM
CHUNK = 128
ROPE_BASE = 10000.0
CONV_CH = D_MODEL
CONV_WIDTH = 31
D_FF = 2816
EPS = 1e-6
N_SUB = 3
MAX_POS_OFFSET = 4096
IN_SPLITS = [RET_QK, RET_QK, RET_V, RET_V, CONV_CH, CONV_CH, D_MODEL, D_MODEL]
IN_COLS = sum(IN_SPLITS)

kernel_name = "hybrid_retention_conformer_macaron_adaln"


def rms_norm(x, g):
    xf = x.astype(jnp.float32)
    y = xf * lax.rsqrt(jnp.mean(xf * xf, axis=-1, keepdims=True) + EPS)
    return (y * g.astype(jnp.float32)).astype(x.dtype)


def layer_norm(x, g, b):
    xf = x.astype(jnp.float32)
    mu = jnp.mean(xf, axis=-1, keepdims=True)
    var = jnp.mean(jnp.square(xf - mu), axis=-1, keepdims=True)
    y = (xf - mu) * lax.rsqrt(var + EPS)
    return (y * g.astype(jnp.float32) + b.astype(jnp.float32)).astype(x.dtype)


def modulate(xn, shift, scale):
    return xn * (1.0 + scale[:, None, :]) + shift[:, None, :]


def swiglu_ffn(x, w_gu, w_d):
    gate, up = jnp.split(x @ w_gu, 2, axis=-1)
    return (jax.nn.silu(gate) * up) @ w_d


def rope(x, positions):
    d = x.shape[-1]
    half = d // 2
    freqs = jnp.power(ROPE_BASE, -jnp.arange(0, half, dtype=jnp.float32) * (2.0 / d))
    ang = positions.astype(jnp.float32)[..., None] * freqs
    cos = jnp.cos(ang)[:, :, None, :]
    sin = jnp.sin(ang)[:, :, None, :]
    x1, x2 = x[..., :half], x[..., half:]
    return jnp.concatenate([x1 * cos - x2 * sin, x1 * sin + x2 * cos], axis=-1)


def retention_chunkwise(q, k, v):
    B, S, H, dk = q.shape
    dv = v.shape[-1]
    n_chunks = S // CHUNK
    log_gamma = jnp.log1p(-jnp.power(2.0, -5.0 - jnp.arange(H, dtype=jnp.float32)))
    idx = jnp.arange(CHUNK, dtype=jnp.float32)
    diff = idx[:, None] - idx[None, :]
    intra = jnp.where(diff[None] >= 0,
                      jnp.exp(log_gamma[:, None, None] * jnp.maximum(diff, 0.0)[None]), 0.0)
    xi = jnp.exp(log_gamma[:, None] * (idx + 1.0))[None, :, :, None]
    zeta = jnp.exp(log_gamma[:, None] * (CHUNK - 1.0 - idx))[None, :, :, None]
    gamma_c = jnp.exp(log_gamma * CHUNK)[None, :, None, None]

    def to_chunks(t):
        d = t.shape[-1]
        return t.reshape(B, n_chunks, CHUNK, H, d).transpose(1, 0, 3, 2, 4)

    def step(state, xs):
        qc, kc, vc = xs
        s = jnp.einsum('bhqd,bhkd->bhqk', qc, kc) * intra
        o = (jnp.einsum('bhqk,bhkv->bhqv', s, vc)
             + jnp.einsum('bhqd,bhdv->bhqv', qc, state) * xi)
        state = state * gamma_c + jnp.einsum('bhkd,bhkv->bhdv', kc * zeta, vc)
        return state, o

    state0 = jnp.zeros((B, H, dk, dv), jnp.float32)
    _, o = lax.scan(step, state0, (to_chunks(q), to_chunks(k), to_chunks(v)))
    return o.transpose(1, 0, 3, 2, 4).reshape(B, S, H, dv)


def head_group_norm(o, g, b):
    mu = jnp.mean(o, axis=-1, keepdims=True)
    var = jnp.mean(jnp.square(o - mu), axis=-1, keepdims=True)
    y = ((o - mu) * lax.rsqrt(var + EPS)).reshape(o.shape[0], o.shape[1], -1)
    return y * g.astype(jnp.float32) + b.astype(jnp.float32)


def hybrid_mixer(xn, positions, w_in, ret_gn_g, ret_gn_b, w_ret_o, w_dw, b_dw,
                 conv_ln_g, conv_ln_b, w_conv_o, b_conv_o, w_out):
    B, S, _ = xn.shape
    z = xn @ w_in
    cuts = list(np.cumsum(IN_SPLITS)[:-1])
    q, k, v, g_ret, glu_a, glu_b, gate_ret, gate_conv = jnp.split(z, cuts, axis=-1)

    qf = rope(q.astype(jnp.float32).reshape(B, S, RET_HEADS, RET_QK_DIM), positions)
    kf = rope(k.astype(jnp.float32).reshape(B, S, RET_HEADS, RET_QK_DIM), positions) * (RET_QK_DIM ** -0.5)
    vf = v.astype(jnp.float32).reshape(B, S, RET_HEADS, RET_V_DIM)
    o = head_group_norm(retention_chunkwise(qf, kf, vf), ret_gn_g, ret_gn_b).astype(xn.dtype)
    y_ret = (jax.nn.silu(g_ret) * o) @ w_ret_o

    u = glu_a * jax.nn.sigmoid(glu_b)
    u = lax.conv_general_dilated(u, w_dw.astype(u.dtype), window_strides=(1,),
                                 padding=[(CONV_WIDTH - 1, 0)],
                                 dimension_numbers=('NWC', 'WIO', 'NWC'),
                                 feature_group_count=CONV_CH) + b_dw
    u = jax.nn.silu(layer_norm(u, conv_ln_g, conv_ln_b))
    y_conv = u @ w_conv_o + b_conv_o

    merged = jax.nn.sigmoid(gate_ret) * y_ret + jax.nn.sigmoid(gate_conv) * y_conv
    return merged @ w_out


def setup_inputs(seed: int = 0) -> dict:
    key = jax.random.key(seed)
    ks = iter(jax.random.split(key, 32))
    f32 = jnp.float32

    def w(shape, fan_in, scale=1.0):
        return jax.random.normal(next(ks), shape, f32) * (scale * fan_in ** -0.5)

    def gain(shape):
        return 1.0 + 0.05 * jax.random.normal(next(ks), shape, f32)

    def bias(shape):
        return 0.02 * jax.random.normal(next(ks), shape, f32)

    L = DEPTH
    x = jax.random.normal(next(ks), (BATCH, SEQ, D_MODEL), f32)
    c = jax.random.normal(next(ks), (BATCH, D_MODEL), f32)
    offset = jax.random.randint(next(ks), (BATCH, 1), 0, MAX_POS_OFFSET, dtype=jnp.int32)
    positions = offset + jnp.arange(SEQ, dtype=jnp.int32)[None, :]
    return {
        "x": x,
        "c": c,
        "positions": positions,
        "w_mod": w((L, D_MODEL, 3 * N_SUB * D_MODEL), D_MODEL),
        "b_mod": bias((L, 3 * N_SUB * D_MODEL)),
        "g_norm1": gain((L, D_MODEL)),
        "w_ffn1_gu": w((L, D_MODEL, 2 * D_FF), D_MODEL),
        "w_ffn1_d": w((L, D_FF, D_MODEL), D_FF),
        "g_norm2": gain((L, D_MODEL)),
        "w_in": w((L, D_MODEL, IN_COLS), D_MODEL),
        "ret_gn_g": gain((L, RET_V)),
        "ret_gn_b": bias((L, RET_V)),
        "w_ret_o": w((L, RET_V, D_MODEL), RET_V),
        "w_dw": w((L, CONV_WIDTH, 1, CONV_CH), CONV_WIDTH),
        "b_dw": bias((L, CONV_CH)),
        "conv_ln_g": gain((L, CONV_CH)),
        "conv_ln_b": bias((L, CONV_CH)),
        "w_conv_o": w((L, CONV_CH, D_MODEL), CONV_CH),
        "b_conv_o": bias((L, D_MODEL)),
        "w_out": w((L, D_MODEL, D_MODEL), D_MODEL),
        "g_norm3": gain((L, D_MODEL)),
        "w_ffn2_gu": w((L, D_MODEL, 2 * D_FF), D_MODEL),
        "w_ffn2_d": w((L, D_FF, D_MODEL), D_FF),
        "g_normf": gain((D_MODEL,)),
    }


def reference(x, c, positions, w_mod, b_mod, g_norm1, w_ffn1_gu, w_ffn1_d, g_norm2,
              w_in, ret_gn_g, ret_gn_b, w_ret_o, w_dw, b_dw, conv_ln_g, conv_ln_b,
              w_conv_o, b_conv_o, w_out, g_norm3, w_ffn2_gu, w_ffn2_d, g_normf):
    h = x
    c_act = jax.nn.silu(c)
    for l in range(DEPTH):
        mod = c_act @ w_mod[l] + b_mod[l]
        (sh1, sc1, gt1, sh2, sc2, gt2, sh3, sc3, gt3) = jnp.split(mod, 3 * N_SUB, axis=-1)
        xn = modulate(rms_norm(h, g_norm1[l]), sh1, sc1)
        h = h + 0.5 * gt1[:, None, :] * swiglu_ffn(xn, w_ffn1_gu[l], w_ffn1_d[l])
        xn = modulate(rms_norm(h, g_norm2[l]), sh2, sc2)
        h = h + gt2[:, None, :] * hybrid_mixer(xn, positions, w_in[l], ret_gn_g[l], ret_gn_b[l],
                                               w_ret_o[l], w_dw[l], b_dw[l], conv_ln_g[l],
                                               conv_ln_b[l], w_conv_o[l], b_conv_o[l], w_out[l])
        xn = modulate(rms_norm(h, g_norm3[l]), sh3, sc3)
        h = h + 0.5 * gt3[:, None, :] * swiglu_ffn(xn, w_ffn2_gu[l], w_ffn2_d[l])
    return rms_norm(h, g_normf)
```

```cpp
#include <hip/hip_runtime.h>
#include <cstdio>
#include <cstdint>
namespace pg8 {
#define PG8_LAS __attribute__((address_space(3)))
typedef unsigned short bf16_t;
typedef short bf16x8 __attribute__((ext_vector_type(8)));
typedef float f32x4 __attribute__((ext_vector_type(4)));
typedef unsigned u32x4 __attribute__((ext_vector_type(4)));
constexpr int BM = 256, BK = 64, HALF = 128, HTB = HALF * BK * 2  , STAGE_BYTES = 8 * HTB, NXCD = 8, WGM = 8;

__host__ __device__ __forceinline__ int lds_byte(int r, int c) { const int st = (r >> 4) * 2 + (c >> 5), rr = r & 15, cc = c & 31, ob = rr * 64 + cc * 2; return st * 1024 + (ob ^ (((ob >> 9) & 1) << 5)); }
__host__ __device__ __forceinline__ void stage_rc(int b, int& R, int& C) { const int st = b / 1024, sb = b % 1024, swz = sb ^ (((sb >> 9) & 1) << 5); R = (st >> 1) * 16 + swz / 64; C = (st & 1) * 32 + (swz % 64) / 2; }
__host__ __device__ __forceinline__ int perm32(int rho) { const int n = rho >> 4, i = rho & 15; return 8 * (i >> 2) + 4 * n + (i & 3); }

struct Unit { int pm, pn; };
struct Gemm { const bf16_t* A; const bf16_t* Bt; int M, N, K; };

struct StaticOrder {
    int nM, nN, nwg, G, c;
    __host__ __device__ void init(int M, int N, int G_, int c_) { nM = M / BM; nN = N / BM; nwg = nM * nN; G = G_; c = c_; }
    __host__ __device__ bool next(int i, Unit& u) const {
        const long L = (long)i * G + c; if (L >= nwg) return false;
        int wgid = (int)L; { const int q = nwg / NXCD, r = nwg % NXCD, xcd = wgid % NXCD, off = wgid / NXCD; wgid = (xcd < r ? xcd * (q + 1) : r * (q + 1) + (xcd - r) * q) + off; }
        const int nig = WGM * nN, gid = wgid / nig, fm = gid * WGM, gsz = (nM - fm) < WGM ? (nM - fm) : WGM;
        u.pm = fm + ((wgid % nig) % gsz); u.pn = (wgid % nig) / gsz; return true;
    }
    __device__ __forceinline__ void a_ready(const Unit&) const {}
    __device__ __forceinline__ void done(const Unit&) const {}
};

__device__ __forceinline__ unsigned cvt_pk_bf16(float lo, float hi) { unsigned r; asm volatile("v_cvt_pk_bf16_f32 %0, %1, %2" : "=v"(r) : "v"(lo), "v"(hi)); return r; }
typedef float f32x2 __attribute__((ext_vector_type(2)));
typedef float f32x2 __attribute__((ext_vector_type(2)));
typedef unsigned u32x2 __attribute__((ext_vector_type(2)));
__device__ __forceinline__ float fast_sigmoid(float x) { return __builtin_amdgcn_rcpf(1.0f + __builtin_amdgcn_exp2f(-1.44269504089f * x)); }
__device__ __forceinline__ float fast_silu(float x) { return x * fast_sigmoid(x); }
typedef __bf16 bf16x2_c __attribute__((ext_vector_type(2)));
__device__ __forceinline__ unsigned cvt2(float lo, float hi) { f32x2 v = {lo, hi}; bf16x2_c b = __builtin_convertvector(v, bf16x2_c); return __builtin_bit_cast(unsigned, b); }
__device__ __forceinline__ u32x4 pack8(const f32x4 a, const f32x4 b) { u32x4 w; w.x = cvt2(a[0], a[1]); w.y = cvt2(a[2], a[3]); w.z = cvt2(b[0], b[1]); w.w = cvt2(b[2], b[3]); return w; }
__device__ __forceinline__ float bf_lo(unsigned w) { return __uint_as_float(w << 16); }
__device__ __forceinline__ float bf_hi(unsigned w) { return __uint_as_float(w & 0xffff0000u); }
__device__ __forceinline__ void unpack8(const u32x4 w, f32x4& a, f32x4& b) { a = (f32x4){bf_lo(w.x), bf_hi(w.x), bf_lo(w.y), bf_hi(w.y)}; b = (f32x4){bf_lo(w.z), bf_hi(w.z), bf_lo(w.w), bf_hi(w.w)}; }

struct EpiSwiGLU {
    static constexpr bool PERM = true, AFTER_DRAIN = false;
    bf16_t* O; int ldc;
    __device__ __forceinline__ void operator()(const f32x4 (&acc)[2][2][4][2], const Unit& u, int wr, int wc, int fr, int fq) const {
        const int row0 = u.pm * BM + wr * 64 + fr, col0 = u.pn * HALF + wc * 32 + 8 * fq;
#pragma unroll
        for (int ai = 0; ai < 2; ++ai)
#pragma unroll
            for (int m = 0; m < 4; ++m) { bf16_t* rowp = O + (size_t)(row0 + ai * HALF + m * 16) * ldc + col0;
                f32x4 v0, v1;
#pragma unroll
                for (int j = 0; j < 4; ++j) { v0[j] = fast_silu(acc[ai][0][m][0][j]) * acc[ai][1][m][0][j]; v1[j] = fast_silu(acc[ai][0][m][1][j]) * acc[ai][1][m][1][j]; }
                *(u32x4*)rowp = pack8(v0, v1); }
    }
};
struct EpiGLU {
    static constexpr bool PERM = true, AFTER_DRAIN = false;
    bf16_t* O; int ldc;
    __device__ __forceinline__ void operator()(const f32x4 (&acc)[2][2][4][2], const Unit& u, int wr, int wc, int fr, int fq) const {
        const int row0 = u.pm * BM + wr * 64 + fr, col0 = u.pn * HALF + wc * 32 + 8 * fq;
#pragma unroll
        for (int ai = 0; ai < 2; ++ai)
#pragma unroll
            for (int m = 0; m < 4; ++m) { bf16_t* rowp = O + (size_t)(row0 + ai * HALF + m * 16) * ldc + col0;
                f32x4 v0, v1;
#pragma unroll
                for (int j = 0; j < 4; ++j) { v0[j] = acc[ai][0][m][0][j] * fast_sigmoid(acc[ai][1][m][0][j]); v1[j] = acc[ai][0][m][1][j] * fast_sigmoid(acc[ai][1][m][1][j]); }
                *(u32x4*)rowp = pack8(v0, v1); }
    }
};
template <int ACT> struct EpiAct {
    static constexpr bool PERM = true, AFTER_DRAIN = false;
    bf16_t* O; int ldc;
    __device__ __forceinline__ void operator()(const f32x4 (&acc)[2][2][4][2], const Unit& u, int wr, int wc, int fr, int fq) const {
        const int row0 = u.pm * BM + wr * 64 + fr, col0 = u.pn * BM + wc * 32 + 8 * fq;
#pragma unroll
        for (int ai = 0; ai < 2; ++ai)
#pragma unroll
            for (int m = 0; m < 4; ++m) { bf16_t* rowp = O + (size_t)(row0 + ai * HALF + m * 16) * ldc + col0;
#pragma unroll
                for (int bj = 0; bj < 2; ++bj) { f32x4 v0 = acc[ai][bj][m][0], v1 = acc[ai][bj][m][1];
#pragma unroll
                    for (int j = 0; j < 4; ++j) { if (ACT == 1) { v0[j] = fast_silu(v0[j]); v1[j] = fast_silu(v1[j]); } if (ACT == 2) { v0[j] = fast_sigmoid(v0[j]); v1[j] = fast_sigmoid(v1[j]); } }
                    *(u32x4*)(rowp + bj * HALF) = pack8(v0, v1); } }
    }
};
struct EpiQKV {
    static constexpr bool PERM = true, AFTER_DRAIN = false;
    bf16_t* Q; bf16_t* Kb; bf16_t* V; const int* pos;
    __device__ __forceinline__ void operator()(const f32x4 (&acc)[2][2][4][2], const Unit& u, int wr, int wc, int fr, int fq) const {
        const int row0 = u.pm * BM + wr * 64 + fr;
        if (u.pn >= 8) {
            const int col0 = (u.pn - 8) * BM + wc * 32 + 8 * fq;
#pragma unroll
            for (int ai = 0; ai < 2; ++ai)
#pragma unroll
                for (int m = 0; m < 4; ++m) { bf16_t* rowp = V + (size_t)(row0 + ai * HALF + m * 16) * 2048 + col0;
#pragma unroll
                    for (int bj = 0; bj < 2; ++bj) *(u32x4*)(rowp + bj * HALF) = pack8(acc[ai][bj][m][0], acc[ai][bj][m][1]); }
            return;
        }
        const bool isk = u.pn >= 4; const int h = u.pn & 3;
        bf16_t* dst = (isk ? Kb : Q) + h * 256 + wc * 32 + 8 * fq;
        const float lg = __builtin_log2f(1.0f - __builtin_exp2f(-5.0f - (float)h));
        const int fi0 = wc * 32 + 8 * fq;
        float inv_freq[8];
#pragma unroll
        for (int j = 0; j < 8; ++j) inv_freq[j] = exp2f(-(float)(fi0 + j) * 0.10381025296523007f) * 0.15915494309189535f;
#pragma unroll
        for (int ai = 0; ai < 2; ++ai)
#pragma unroll
            for (int m = 0; m < 4; ++m) { const int row = row0 + ai * HALF + m * 16; const float p = (float)pos[row]; const float sl = (float)(row & 127);
                const float dec = isk ? exp2f(-sl * lg) * 0.0625f : exp2f(sl * lg);
                f32x4 o1[2], o2[2];
#pragma unroll
                for (int n = 0; n < 2; ++n)
#pragma unroll
                    for (int j = 0; j < 4; ++j) { float t = p * inv_freq[4 * n + j]; t = t - floorf(t);
                        const float sn = __builtin_amdgcn_sinf(t), cs = __builtin_amdgcn_cosf(t);
                        const float x1 = acc[ai][0][m][n][j], x2 = acc[ai][1][m][n][j];
                        o1[n][j] = (x1 * cs - x2 * sn) * dec; o2[n][j] = (x1 * sn + x2 * cs) * dec; }
                bf16_t* rowp = dst + (size_t)row * 1024;
                *(u32x4*)rowp = pack8(o1[0], o1[1]); *(u32x4*)(rowp + HALF) = pack8(o2[0], o2[1]); }
    }
};
struct EpiResid {
    static constexpr bool PERM = false, AFTER_DRAIN = false;
    const float* base; float* out; const float* gate; int gs; float scale;
    __device__ __forceinline__ void operator()(const f32x4 (&acc)[2][2][4][2], const Unit& u, int wr, int wc, int fr, int fq) const {
        const int row0 = u.pm * BM + wr * 64 + fr, col0 = u.pn * BM + wc * 32 + 4 * fq;
        const float* gp = gate + (size_t)(u.pm >> 3) * gs + col0;
        f32x4 gv[2][2];
#pragma unroll
        for (int bj = 0; bj < 2; ++bj)
#pragma unroll
            for (int n = 0; n < 2; ++n) gv[bj][n] = *(const f32x4*)(gp + bj * HALF + n * 16) * scale;
#pragma unroll
        for (int ai = 0; ai < 2; ++ai)
#pragma unroll
            for (int m = 0; m < 4; ++m) { const size_t off = (size_t)(row0 + ai * HALF + m * 16) * 1024 + col0;
#pragma unroll
                for (int bj = 0; bj < 2; ++bj)
#pragma unroll
                    for (int n = 0; n < 2; ++n) { const f32x4 bs = *(const f32x4*)(base + off + bj * HALF + n * 16); *(f32x4*)(out + off + bj * HALF + n * 16) = bs + gv[bj][n] * acc[ai][bj][m][n]; } }
    }
};
struct EpiConvO {
    static constexpr bool PERM = true, AFTER_DRAIN = false;
    bf16_t* T; const bf16_t* G; const float* bias;
    __device__ __forceinline__ void operator()(const f32x4 (&acc)[2][2][4][2], const Unit& u, int wr, int wc, int fr, int fq) const {
        const int row0 = u.pm * BM + wr * 64 + fr, col0 = u.pn * BM + wc * 32 + 8 * fq;
        f32x4 bv[2][2];
#pragma unroll
        for (int bj = 0; bj < 2; ++bj)
#pragma unroll
            for (int n = 0; n < 2; ++n) bv[bj][n] = *(const f32x4*)(bias + col0 + bj * HALF + 4 * n);
#pragma unroll
        for (int ai = 0; ai < 2; ++ai)
#pragma unroll
            for (int m = 0; m < 4; ++m) { const size_t row = (size_t)(row0 + ai * HALF + m * 16);
#pragma unroll
                for (int bj = 0; bj < 2; ++bj) { f32x4 g0, g1; unpack8(*(const u32x4*)(G + row * 2048 + 1024 + col0 + bj * HALF), g0, g1);
                    *(u32x4*)(T + row * 1024 + col0 + bj * HALF) = pack8(g0 * (acc[ai][bj][m][0] + bv[bj][0]), g1 * (acc[ai][bj][m][1] + bv[bj][1])); } }
    }
};
struct EpiRetO {
    static constexpr bool PERM = true, AFTER_DRAIN = false;
    bf16_t* T; const bf16_t* G;
    __device__ __forceinline__ void operator()(const f32x4 (&acc)[2][2][4][2], const Unit& u, int wr, int wc, int fr, int fq) const {
        const int row0 = u.pm * BM + wr * 64 + fr, col0 = u.pn * BM + wc * 32 + 8 * fq;
#pragma unroll
        for (int ai = 0; ai < 2; ++ai)
#pragma unroll
            for (int m = 0; m < 4; ++m) { const size_t row = (size_t)(row0 + ai * HALF + m * 16);
#pragma unroll
                for (int bj = 0; bj < 2; ++bj) { f32x4 g0, g1, t0, t1; unpack8(*(const u32x4*)(G + row * 2048 + col0 + bj * HALF), g0, g1); unpack8(*(const u32x4*)(T + row * 1024 + col0 + bj * HALF), t0, t1);
                    *(u32x4*)(T + row * 1024 + col0 + bj * HALF) = pack8(t0 + g0 * acc[ai][bj][m][0], t1 + g1 * acc[ai][bj][m][1]); } }
    }
};
template <class Epi, class Sched, bool ALIGN_EPI = false, bool SP2 = false>
__device__ __forceinline__ void gemm_phase(PG8_LAS unsigned char* lds, const Gemm g, const Sched& S, const Epi& E) {
    const int tid = threadIdx.x, wid = __builtin_amdgcn_readfirstlane(tid >> 6), lane = tid & 63, wr = wid >> 2, wc = wid & 3, fr = lane & 15, fq = lane >> 4;
    const int K = g.K, nt = K / BK;
    unsigned voffA[2], voffB[2];
#pragma unroll
    for (int i = 0; i < 2; ++i) { int R, C; stage_rc(tid * 16 + i * 8192, R, C); const int Rb = Epi::PERM ? ((R & ~31) + perm32(R & 31)) : R;
        voffA[i] = (unsigned)(R * K + C) * 2u; voffB[i] = (unsigned)(Rb * K + C) * 2u; }
    const size_t kstep = (size_t)(BK * 2);
    const size_t hstep = (size_t)HALF * K * 2;
    const size_t tstep = 2 * hstep;
    const unsigned ldsw = (unsigned)wid * 1024u;
    const int aoff = lds_byte(wr * 64 + fr, fq * 8), boff = lds_byte(wc * 32 + fr, fq * 8);
#define PG8_SA(b, h) (((b) * 2 + (h)) * HTB)
#define PG8_SB(b, h) ((4 + (b) * 2 + (h)) * HTB)
#define PG8_STAGE(bufoff, gbase, voff) do { _Pragma("unroll") for (int _i = 0; _i < 2; ++_i) \
        __builtin_amdgcn_global_load_lds((const unsigned*)((const char*)(gbase) + (voff)[_i]), (PG8_LAS unsigned*)(lds + (bufoff) + ldsw + _i * 8192), 16, 0, 0); } while (0)
#define PG8_LDA(dst, b, h) do { _Pragma("unroll") for (int m = 0; m < 4; ++m) _Pragma("unroll") for (int k = 0; k < 2; ++k) dst[m][k] = *(const PG8_LAS bf16x8*)(lds + PG8_SA(b, h) + aoff + m * 2048 + k * 1024); } while (0)
#define PG8_LDB(dst, b, h) do { _Pragma("unroll") for (int n = 0; n < 2; ++n) _Pragma("unroll") for (int k = 0; k < 2; ++k) dst[n][k] = *(const PG8_LAS bf16x8*)(lds + PG8_SB(b, h) + boff + n * 2048 + k * 1024); } while (0)
#define PG8_MMA(ai, bj, At, Bt) do { __builtin_amdgcn_s_setprio(1); _Pragma("unroll") for (int m = 0; m < 4; ++m) _Pragma("unroll") for (int n = 0; n < 2; ++n) _Pragma("unroll") for (int k = 0; k < 2; ++k) \
        acc[ai][bj][m][n] = __builtin_amdgcn_mfma_f32_16x16x32_bf16(Bt[n][k], At[m][k], acc[ai][bj][m][n], 0, 0, 0); __builtin_amdgcn_s_setprio(0); } while (0)
#define PG8_WAIT_V(n) asm volatile("s_waitcnt vmcnt(" #n ")" ::: "memory")
#define PG8_WAIT_L(n) asm volatile("s_waitcnt lgkmcnt(" #n ")" ::: "memory")
#define PG8_BAR __builtin_amdgcn_s_barrier()
#define PG8_SCHED __builtin_amdgcn_sched_barrier(0)
    Unit cur, nxt; int ui = 0;
    if (!S.next(0, cur)) return;
    f32x4 acc[2][2][4][2];
#pragma unroll
    for (int a = 0; a < 2; ++a)
#pragma unroll
        for (int b = 0; b < 2; ++b)
#pragma unroll
            for (int m = 0; m < 4; ++m)
#pragma unroll
                for (int n = 0; n < 2; ++n) acc[a][b][m][n] = (f32x4){0.f, 0.f, 0.f, 0.f};
    bf16x8 At[4][2], B0[2][2], B1[2][2];
    const char* cA = (const char*)g.A + (size_t)cur.pm * tstep; const char* cB = (const char*)g.Bt + (size_t)cur.pn * tstep;
    S.a_ready(cur);
    if constexpr (SP2) {
        PG8_STAGE(PG8_SB(0, 0), cB, voffB); PG8_STAGE(PG8_SB(0, 1), cB + hstep, voffB); PG8_STAGE(PG8_SA(0, 0), cA, voffA); PG8_STAGE(PG8_SA(0, 1), cA + hstep, voffA);
        if (wr == 1) PG8_BAR;
        PG8_WAIT_V(2); PG8_BAR;
        PG8_STAGE(PG8_SB(1, 0), cB + kstep, voffB); PG8_STAGE(PG8_SA(1, 0), cA + kstep, voffA); PG8_STAGE(PG8_SB(1, 1), cB + hstep + kstep, voffB);
        PG8_WAIT_V(6); PG8_BAR;
    } else {
        PG8_STAGE(PG8_SB(0, 0), cB, voffB); PG8_STAGE(PG8_SA(0, 0), cA, voffA); PG8_STAGE(PG8_SB(0, 1), cB + hstep, voffB); PG8_STAGE(PG8_SA(0, 1), cA + hstep, voffA);
        if (wr == 1) PG8_BAR;
        PG8_WAIT_V(4); PG8_BAR;
        PG8_STAGE(PG8_SB(1, 0), cB + kstep, voffB); PG8_STAGE(PG8_SA(1, 0), cA + kstep, voffA); PG8_STAGE(PG8_SB(1, 1), cB + hstep + kstep, voffB);
        PG8_WAIT_V(6); PG8_BAR;
    }
    for (;;) {
        const bool has_next = S.next(ui + 1, nxt);
        const char* nA = has_next ? (const char*)g.A + (size_t)nxt.pm * tstep : cA; const char* nB = has_next ? (const char*)g.Bt + (size_t)nxt.pn * tstep : cB;
        for (int t = 0; t < nt; t += 2) {
            const bool last = (t == nt - 2);
            const char* a1 = cA + (size_t)(t + 1) * kstep;
            const char* a2 = last ? nA : cA + (size_t)(t + 2) * kstep; const char* b2 = last ? nB : cB + (size_t)(t + 2) * kstep;
            const char* a3 = a2 + kstep; const char* b3 = b2 + kstep;
            if (last && has_next) S.a_ready(nxt);
            if constexpr (SP2) {
            PG8_LDB(B0, 0, 0); PG8_LDB(B1, 0, 1); PG8_SCHED; PG8_LDA(At, 0, 0); PG8_STAGE(PG8_SA(1, 1), a1 + hstep, voffA);
            PG8_WAIT_V(8); PG8_WAIT_L(0); PG8_BAR; PG8_MMA(0, 0, At, B0); PG8_MMA(0, 1, At, B1); PG8_BAR; PG8_SCHED;
            PG8_LDA(At, 0, 1); PG8_STAGE(PG8_SB(0, 0), b2, voffB); PG8_STAGE(PG8_SB(0, 1), b2 + hstep, voffB); PG8_STAGE(PG8_SA(0, 0), a2, voffA);
            PG8_WAIT_V(8); PG8_WAIT_L(0); PG8_BAR; PG8_MMA(1, 0, At, B0); PG8_MMA(1, 1, At, B1); PG8_BAR; PG8_SCHED;
            PG8_LDB(B0, 1, 0); PG8_LDB(B1, 1, 1); PG8_SCHED; PG8_LDA(At, 1, 0); PG8_STAGE(PG8_SA(0, 1), a2 + hstep, voffA);
            PG8_WAIT_V(8); PG8_WAIT_L(0); PG8_BAR; PG8_MMA(0, 0, At, B0); PG8_MMA(0, 1, At, B1); PG8_BAR; PG8_SCHED;
            PG8_LDA(At, 1, 1); PG8_STAGE(PG8_SB(1, 0), b3, voffB); PG8_STAGE(PG8_SB(1, 1), b3 + hstep, voffB); PG8_STAGE(PG8_SA(1, 0), a3, voffA);
            PG8_WAIT_V(8); PG8_WAIT_L(0); PG8_BAR; PG8_MMA(1, 0, At, B0); PG8_MMA(1, 1, At, B1); PG8_BAR; PG8_SCHED;
            } else {
            PG8_LDB(B0, 0, 0); PG8_SCHED; PG8_LDA(At, 0, 0); PG8_STAGE(PG8_SA(1, 1), a1 + hstep, voffA);
            PG8_WAIT_L(8); PG8_BAR; PG8_WAIT_L(0); PG8_MMA(0, 0, At, B0); PG8_BAR; PG8_SCHED;
            PG8_LDB(B1, 0, 1); PG8_STAGE(PG8_SB(0, 0), b2, voffB);
            PG8_BAR; PG8_WAIT_L(0); PG8_MMA(0, 1, At, B1); PG8_BAR;
            PG8_LDA(At, 0, 1); PG8_STAGE(PG8_SA(0, 0), a2, voffA);
            PG8_BAR; PG8_WAIT_L(0); PG8_MMA(1, 0, At, B0); PG8_BAR; PG8_SCHED;
            PG8_STAGE(PG8_SB(0, 1), b2 + hstep, voffB);
            PG8_WAIT_V(6); PG8_BAR; PG8_MMA(1, 1, At, B1); PG8_BAR;
            PG8_LDB(B0, 1, 0); PG8_SCHED; PG8_LDA(At, 1, 0); PG8_STAGE(PG8_SA(0, 1), a2 + hstep, voffA);
            PG8_WAIT_L(8); PG8_BAR; PG8_WAIT_L(0); PG8_MMA(0, 0, At, B0); PG8_BAR; PG8_SCHED;
            PG8_LDB(B1, 1, 1); PG8_STAGE(PG8_SB(1, 0), b3, voffB);
            PG8_BAR; PG8_WAIT_L(0); PG8_MMA(0, 1, At, B1); PG8_BAR;
            PG8_LDA(At, 1, 1); PG8_STAGE(PG8_SA(1, 0), a3, voffA);
            PG8_BAR; PG8_WAIT_L(0); PG8_MMA(1, 0, At, B0); PG8_BAR; PG8_SCHED;
            PG8_STAGE(PG8_SB(1, 1), b3 + hstep, voffB);
            PG8_WAIT_V(6); PG8_BAR; PG8_MMA(1, 1, At, B1); PG8_BAR;
            }
        }
        if constexpr (ALIGN_EPI) { if (wr == 0) PG8_BAR; }
        if constexpr (!Epi::AFTER_DRAIN) { E(acc, cur, wr, wc, fr, fq); S.done(cur); }
        if (!has_next) break;
#pragma unroll
        for (int a = 0; a < 2; ++a)
#pragma unroll
            for (int b = 0; b < 2; ++b)
#pragma unroll
                for (int m = 0; m < 4; ++m)
#pragma unroll
                    for (int n = 0; n < 2; ++n) acc[a][b][m][n] = (f32x4){0.f, 0.f, 0.f, 0.f};
        cur = nxt; cA = nA; cB = nB; ++ui;
        if constexpr (ALIGN_EPI) { if (wr == 1) PG8_BAR; }
    }
    PG8_WAIT_V(0);
    if constexpr (!ALIGN_EPI) { if (wr == 0) PG8_BAR; }
    PG8_BAR;
    if constexpr (Epi::AFTER_DRAIN) { E.fused(acc, cur, wr, wc, fr, fq, lds, wid, lane); S.done(cur); }
#undef PG8_SA
#undef PG8_SB
#undef PG8_STAGE
#undef PG8_LDA
#undef PG8_LDB
#undef PG8_MMA
#undef PG8_WAIT_V
#undef PG8_WAIT_L
#undef PG8_BAR
#undef PG8_SCHED
}
}
#define GAS __attribute__((address_space(1)))
#define LAS __attribute__((address_space(3)))
typedef unsigned short bf16;
typedef unsigned v4u __attribute__((ext_vector_type(4)));
typedef float f32x4 __attribute__((ext_vector_type(4)));
typedef short bf16x8 __attribute__((ext_vector_type(8)));
typedef GAS unsigned gu32;
typedef GAS unsigned long long gu64;
#define RLX_AGENT __ATOMIC_RELAXED, __HIP_MEMORY_SCOPE_AGENT
#define LDS_WAIT() asm volatile("s_waitcnt lgkmcnt(0)" ::: "memory")
#define VM_WAIT() asm volatile("s_waitcnt vmcnt(0)" ::: "memory")
__device__ __forceinline__ unsigned long long rt() { return __builtin_amdgcn_s_memrealtime(); }
__device__ __forceinline__ unsigned f2bf(float f) { unsigned u = __builtin_bit_cast(unsigned, f); return (u + 0x7fffu + ((u >> 16) & 1u)) >> 16; }
__device__ __forceinline__ unsigned pk2(float lo, float hi) { return f2bf(lo) | (f2bf(hi) << 16); }

#define XB_TMO      128
#define XB_XCNT(j)  (256  + 64 * (j))
#define XB_XSUB(j)  (1280 + 64 * (j))
#define XB_XGEN(j)  (2304 + 64 * (j))
#define XB_TOP      3328
#define XB_TOPGEN   3392
#define XCD_BAR_WORDS 3456
#define XB_SPIN_CAP (1u << 18)

__device__ __forceinline__ unsigned xb_ld(unsigned* p)              { return __hip_atomic_load(p, __ATOMIC_RELAXED, __HIP_MEMORY_SCOPE_AGENT); }
__device__ __forceinline__ unsigned xb_add(unsigned* p, unsigned v) { return __hip_atomic_fetch_add(p, v, __ATOMIC_RELAXED, __HIP_MEMORY_SCOPE_AGENT); }
__device__ __forceinline__ unsigned xb_xcc_id() { return (unsigned)__builtin_amdgcn_s_getreg((3 << 11) | 20) & 0xFu; }
#define XB_SPIN(cond, bar) do { unsigned _sp = 0; while (cond) { __builtin_amdgcn_s_sleep(1); \
    if ((++_sp & 255u) == 0u) { if (xb_ld(&(bar)[XB_TMO])) break; if (_sp > XB_SPIN_CAP) { atomicAdd(&(bar)[XB_TMO], 1u); break; } } } } while (0)

struct XcdBarrier {
    unsigned* bar; unsigned x;
    volatile LAS unsigned* st;
};

__device__ __forceinline__ XcdBarrier xcd_barrier_post(unsigned* bar, volatile LAS unsigned* st) {
    XcdBarrier b; b.bar = bar; b.x = xb_xcc_id(); b.st = st;
    if (threadIdx.x == 0) (void)xb_add(&bar[XB_XCNT(b.x)], 1u);
    return b;
}
__device__ __forceinline__ void xcd_barrier_complete(unsigned* bar, unsigned x, unsigned& nloc, unsigned& nx) {
    const unsigned G = gridDim.x * gridDim.y * gridDim.z;
    unsigned sum, cnt, mine, sp = 0u;
    for (;;) {
        sum = 0u; cnt = 0u; mine = 0u;
#pragma unroll
        for (unsigned j = 0; j < 16; ++j) { const unsigned c = xb_ld(&bar[XB_XCNT(j)]); sum += c; cnt += (c > 0u) ? 1u : 0u; mine = (j == x) ? c : mine; }
        if (sum == G) break;
        __builtin_amdgcn_s_sleep(1);
        if ((++sp & 255u) == 0u) { if (xb_ld(&bar[XB_TMO])) break; if (sp > XB_SPIN_CAP) { atomicAdd(&bar[XB_TMO], 1u); break; } }
    }
    nloc = mine > 0u ? mine : 1u; nx = cnt > 0u ? cnt : 1u;
}

__device__ __forceinline__ void xcd_barrier(const XcdBarrier& b) {
    asm volatile("s_waitcnt vmcnt(0)" ::: "memory");
    __syncthreads();
    if (threadIdx.x == 0) {
        unsigned* bar = b.bar;
        __builtin_amdgcn_s_waitcnt(0);
        unsigned nloc = b.st[0], nx = b.st[1];
        if (nloc == 0u) { xcd_barrier_complete(bar, b.x, nloc, nx); b.st[0] = nloc; b.st[1] = nx; }
        const unsigned old = xb_add(&bar[XB_XSUB(b.x)], 1u);
        const unsigned gen = old / nloc;
        if (old + 1u == (gen + 1u) * nloc) {
            __builtin_amdgcn_fence(__ATOMIC_RELEASE, "agent");
            asm volatile("s_waitcnt vmcnt(0)" ::: "memory");
            const unsigned og = xb_add(&bar[XB_TOP], 1u);
            const unsigned tg = og / nx;
            if (og + 1u == (tg + 1u) * nx) xb_add(&bar[XB_TOPGEN], 1u);
            else XB_SPIN(xb_ld(&bar[XB_TOPGEN]) == tg, bar);
            __builtin_amdgcn_fence(__ATOMIC_ACQUIRE, "agent");
            xb_add(&bar[XB_XGEN(b.x)], 1u);
            asm volatile("s_waitcnt vmcnt(0)" ::: "memory");
        } else {
            XB_SPIN(xb_ld(&bar[XB_XGEN(b.x)]) == gen, bar);
            __builtin_amdgcn_fence(__ATOMIC_ACQUIRE, "agent");
            asm volatile("s_waitcnt vmcnt(0)" ::: "memory");
        }
    }
    __syncthreads();
}

__device__ __forceinline__ float wave_sum(float v) {
#pragma unroll
    for (int o = 1; o < 64; o <<= 1) v += __shfl_xor(v, o);
    return v;
}
__device__ __forceinline__ float bfl(unsigned w) { return __uint_as_float(w << 16); }
__device__ __forceinline__ float bfh(unsigned w) { return __uint_as_float(w & 0xffff0000u); }
__device__ __forceinline__ float sigm(float x) { return __builtin_amdgcn_rcpf(1.0f + __builtin_amdgcn_exp2f(-1.44269504089f * x)); }

__device__ __forceinline__ void gn_phase(bf16* OY, const bf16* SG, const float* gg, const float* gb, int lane, int gw, int NGW) {
    for (int tb = gw; tb < (32768 / 64) * 4; tb += NGW) {
        const int h = tb & 3, t0 = (tb >> 2) * 64, c0 = h * 512 + 8 * lane;
        const f32x4 g0 = *(const GAS f32x4*)(gg + c0), g1 = *(const GAS f32x4*)(gg + c0 + 4), b0 = *(const GAS f32x4*)(gb + c0), b1 = *(const GAS f32x4*)(gb + c0 + 4);
        for (int r = 0; r < 64; ++r) { const size_t off = (size_t)(t0 + r) * 2048 + c0;
            const v4u ow = *(const GAS v4u*)(OY + off), sw = *(const GAS v4u*)(SG + off);
            f32x4 o0 = (f32x4){bfl(ow.x), bfh(ow.x), bfl(ow.y), bfh(ow.y)}, o1 = (f32x4){bfl(ow.z), bfh(ow.z), bfl(ow.w), bfh(ow.w)};
            const f32x4 s0 = (f32x4){bfl(sw.x), bfh(sw.x), bfl(sw.y), bfh(sw.y)}, s1 = (f32x4){bfl(sw.z), bfh(sw.z), bfl(sw.w), bfh(sw.w)};
            const float mean = wave_sum((o0.x + o0.y) + (o0.z + o0.w) + (o1.x + o1.y) + (o1.z + o1.w)) * (1.0f / 512.0f);
            o0 = o0 - mean; o1 = o1 - mean;
            const float var = wave_sum((o0.x * o0.x + o0.y * o0.y) + (o0.z * o0.z + o0.w * o0.w) + (o1.x * o1.x + o1.y * o1.y) + (o1.z * o1.z + o1.w * o1.w)) * (1.0f / 512.0f);
            const float rstd = 1.0f / sqrtf(var + 1e-6f);
            const f32x4 y0 = (o0 * rstd * g0 + b0) * s0, y1 = (o1 * rstd * g1 + b1) * s1;
            v4u w; w.x = pk2(y0.x, y0.y); w.y = pk2(y0.z, y0.w); w.z = pk2(y1.x, y1.y); w.w = pk2(y1.z, y1.w);
            *(GAS v4u*)(OY + off) = w; }
    }
}

__device__ __forceinline__ void conv_phase(LAS unsigned char* lds, const bf16* U, const float* wdw, const float* bdw, const float* lg, const float* lb, bf16* UC, int tid, int lane, int wave, int G) {
    constexpr int T = 32, ROWS = T + 30;
    LAS unsigned* tile = (LAS unsigned*)lds;
    LAS float* red = (LAS float*)(lds + ROWS * 2048);
    LAS float* stats = red + 8 * 32 * 2;
    const int c0 = 2 * tid;
    float w0[31], w1[31];
#pragma unroll
    for (int t = 0; t < 31; ++t) { w0[t] = wdw[t * 1024 + c0]; w1[t] = wdw[t * 1024 + c0 + 1]; }
    const float bd0 = bdw[c0], bd1 = bdw[c0 + 1], g0 = lg[c0], g1 = lg[c0 + 1], b0 = lb[c0], b1 = lb[c0 + 1];
    for (int tl = blockIdx.x; tl < 32768 / T; tl += G) {
        const int row_base = tl * T, s0 = row_base % 2048;
        for (int e = tid; e < ROWS * 128; e += 512) { const int r = e >> 7, p = e & 127; v4u val = (v4u){0u, 0u, 0u, 0u};
            if (s0 - 30 + r >= 0) val = *(const GAS v4u*)(U + (size_t)(row_base - 30 + r) * 1024 + p * 8);
            *(LAS v4u*)(lds + r * 2048 + p * 16) = val; }
        __syncthreads();
        float a0[T], a1[T];
#pragma unroll
        for (int j = 0; j < T; ++j) { a0[j] = bd0; a1[j] = bd1; }
#pragma unroll
        for (int r = 0; r < ROWS; ++r) { const unsigned xw = tile[r * 512 + tid]; const float x0 = bfl(xw), x1 = bfh(xw);
#pragma unroll
            for (int t = 0; t < 31; ++t) { const int j = r - t; if (j >= 0 && j < T) { a0[j] += w0[t] * x0; a1[j] += w1[t] * x1; } } }
#pragma unroll
        for (int j = 0; j < T; ++j) { const float s = wave_sum(a0[j] + a1[j]), q = wave_sum(a0[j] * a0[j] + a1[j] * a1[j]);
            if (lane == 0) { red[(wave * 32 + j) * 2] = s; red[(wave * 32 + j) * 2 + 1] = q; } }
        __syncthreads();
        if (tid < 32) { float S = 0.f, Q = 0.f;
#pragma unroll
            for (int w = 0; w < 8; ++w) { S += red[(w * 32 + tid) * 2]; Q += red[(w * 32 + tid) * 2 + 1]; }
            const float mean = S * (1.0f / 1024.0f); float var = Q * (1.0f / 1024.0f) - mean * mean; var = var < 0.f ? 0.f : var;
            stats[tid * 2] = mean; stats[tid * 2 + 1] = 1.0f / sqrtf(var + 1e-6f); }
        __syncthreads();
#pragma unroll
        for (int j = 0; j < T; ++j) { const float mean = stats[2 * j], rstd = stats[2 * j + 1];
            float y0 = (a0[j] - mean) * rstd * g0 + b0, y1 = (a1[j] - mean) * rstd * g1 + b1;
            y0 = y0 * sigm(y0); y1 = y1 * sigm(y1);
            *(GAS unsigned*)(UC + (size_t)(row_base + j) * 1024 + c0) = pk2(y0, y1); }
        __syncthreads();
    }
}

__device__ __forceinline__ void retention_phase(LAS unsigned char* lds, const bf16* Q, const bf16* Kb, bf16* V, int tid, int lane, int wave, int G) {
    LAS bf16* qs = (LAS bf16*)lds;
    LAS bf16* ks = (LAS bf16*)(lds + 32768);
    LAS bf16* vs = (LAS bf16*)(lds + 65536);
    LAS float* po = (LAS float*)(lds + 81920);
    const int d = tid & 127, qq = tid >> 7;
    for (int un = blockIdx.x; un < 256; un += G) {
        const int sl = un & 3, h = (un >> 2) & 3, b = un >> 4;
        const float gC = expf(128.0f * log1pf(-exp2f(-5.0f - (float)h)));
        float st[64];
#pragma unroll
        for (int i = 0; i < 64; ++i) st[i] = 0.f;
        for (int hc = 0; hc < 2048 / 64; ++hc) {
            const size_t row0 = (size_t)b * 2048 + hc * 64;
            if (hc > 0 && (hc & 1) == 0) {
#pragma unroll
                for (int i = 0; i < 64; ++i) st[i] *= gC; }
            __syncthreads();
            for (int e = tid; e < 2048; e += 512) { const int r = e >> 5, p = e & 31;
                *(LAS v4u*)(qs + r * 256 + p * 8) = *(const GAS v4u*)(Q + (row0 + r) * 1024 + h * 256 + p * 8);
                *(LAS v4u*)(ks + r * 256 + p * 8) = *(const GAS v4u*)(Kb + (row0 + r) * 1024 + h * 256 + p * 8); }
            for (int e = tid; e < 1024; e += 512) { const int r = e >> 4, p = e & 15;
                *(LAS v4u*)(vs + r * 128 + p * 8) = *(const GAS v4u*)(V + (row0 + r) * 2048 + h * 512 + sl * 128 + p * 8); }
            __syncthreads();
            for (int tb = 0; tb < 4; ++tb) {
                for (int tt = 0; tt < 16; ++tt) { const int n = tb * 16 + tt;
                    const float vv = __uint_as_float(((unsigned)vs[n * 128 + d]) << 16);
                    float acc = 0.f;
#pragma unroll
                    for (int i8 = 0; i8 < 8; ++i8) { const v4u kw = *(const LAS v4u*)(ks + n * 256 + qq * 64 + i8 * 8), qw = *(const LAS v4u*)(qs + n * 256 + qq * 64 + i8 * 8);
                        const float kf[8] = {bfl(kw.x), bfh(kw.x), bfl(kw.y), bfh(kw.y), bfl(kw.z), bfh(kw.z), bfl(kw.w), bfh(kw.w)};
                        const float qf[8] = {bfl(qw.x), bfh(qw.x), bfl(qw.y), bfh(qw.y), bfl(qw.z), bfh(qw.z), bfl(qw.w), bfh(qw.w)};
#pragma unroll
                        for (int e = 0; e < 8; ++e) { st[i8 * 8 + e] += kf[e] * vv; acc += qf[e] * st[i8 * 8 + e]; } }
                    po[(tt * 4 + qq) * 128 + d] = acc; }
                __syncthreads();
                for (int e = tid; e < 2048; e += 512) { const int tt = e >> 7, dd = e & 127;
                    const float s = (po[(tt * 4 + 0) * 128 + dd] + po[(tt * 4 + 1) * 128 + dd]) + (po[(tt * 4 + 2) * 128 + dd] + po[(tt * 4 + 3) * 128 + dd]);
                    V[(row0 + tb * 16 + tt) * 2048 + h * 512 + sl * 128 + dd] = (bf16)f2bf(s); }
                __syncthreads();
            }
        }
    }
}

#ifndef PG8_SP2
#define PG8_SP2 true
#endif
#ifndef PG8_ALIGN
#define PG8_ALIGN true
#endif
#ifndef MK_CHECK
#define MK_CHECK 0
#endif
#ifndef MK_N_LAUNCHES
#define MK_N_LAUNCHES 1
#endif
constexpr int NWAVES = 8;
constexpr int BATCH = 16, SEQ = 2048, D = 1024, M = BATCH * SEQ, DFF = 2816, NGU = 2 * DFF, NIN = 10240, RV = 2048, NMOD = 9 * D, CHUNK = 128, CONVW = 31;
constexpr float EPS = 1e-6f;
constexpr int NPHASE = 19;
constexpr int N_LAUNCHES = MK_N_LAUNCHES;
constexpr size_t MiB = 1u << 20;
constexpr size_t WS_CTL = 0, CTL_ZERO_BYTES = 2 * MiB;
constexpr size_t WS_MOD = 1 * MiB;
constexpr size_t WS_W = 2 * MiB;
constexpr size_t WE_GU1 = 0, WE_D1 = WE_GU1 + (size_t)D * NGU, WE_IN = WE_D1 + (size_t)DFF * D, WE_RO = WE_IN + (size_t)D * NIN, WE_CO = WE_RO + (size_t)RV * D,
                 WE_OUT = WE_CO + (size_t)D * D, WE_GU2 = WE_OUT + (size_t)D * D, WE_D2 = WE_GU2 + (size_t)D * NGU, WE_END = WE_D2 + (size_t)DFF * D;
static_assert(WS_W + WE_END * 2 <= 64 * MiB, "weights fit [2, 64) MiB");
constexpr size_t WS_XN = 64 * MiB;
constexpr size_t WS_ACT = 128 * MiB;
constexpr size_t WS_U = 128 * MiB, WS_Q = 128 * MiB, WS_K = 192 * MiB, WS_V = 256 * MiB, WS_SG = 128 * MiB, WS_G2 = 128 * MiB, WS_T = 384 * MiB, WS_UC = 448 * MiB, WS_END = 512 * MiB;
static_assert(WS_ACT + (size_t)M * DFF * 2 <= WS_END, "act fits");
constexpr int CW_BAR = 4096;

constexpr int RING_OFF = 0, RING_BYTES = 131072;
constexpr int LDSCTL_OFF = RING_BYTES, MISC_OFF = LDSCTL_OFF + 320;
constexpr int LDS_BYTES = 147456;
static_assert(MISC_OFF + 128 <= LDS_BYTES, "LDS map");

struct Args { const float* in[24]; float* out; unsigned char* ws; int ph_lo, ph_hi, li, pad; };

__device__ __forceinline__ int src_col(int mode, int nn) {
    if (mode == 1) { const int blk = nn >> 8, w = nn & 255; return (w < 128) ? (blk * 128 + w) : (DFF + blk * 128 + (w - 128)); }
    if (mode == 2) { if (nn >= 6144 && nn < 8192) { const int t = nn - 6144, blk = t >> 8, w = t & 255; return (w < 128) ? (6144 + blk * 128 + w) : (7168 + blk * 128 + (w - 128)); } return nn; }
    return nn;
}
__device__ __forceinline__ void p0_transpose_item(const float* W, int K, int N, bf16* WT, int mode, LAS float* scr, int item, int lane) {
    const int nblk = N / 32, kb = item / nblk, nb = item % nblk, k0 = 64 * kb, n0 = 32 * nb;
    const int sc = src_col(mode, n0 + (lane & 31));
#pragma unroll 8
    for (int i = 0; i < 32; ++i) { const int kk = 2 * i + (lane >> 5); scr[kk * 33 + (lane & 31)] = W[(size_t)(k0 + kk) * N + sc]; }
    LDS_WAIT(); asm volatile("" ::: "memory");
    const int c = lane & 7;
#pragma unroll
    for (int j = 0; j < 4; ++j) { const int n = (lane >> 3) + 8 * j; const LAS float* s = scr + (8 * c) * 33 + n;
        v4u o; o.x = pk2(s[0 * 33], s[1 * 33]); o.y = pk2(s[2 * 33], s[3 * 33]); o.z = pk2(s[4 * 33], s[5 * 33]); o.w = pk2(s[6 * 33], s[7 * 33]);
        *(GAS v4u*)(WT + (size_t)(n0 + n) * K + k0 + 8 * c) = o; }
    LDS_WAIT(); asm volatile("" ::: "memory");
}

__device__ __forceinline__ void modnorm_rows(const float* h, const float* g, const float* sh, const float* sc, bf16* xn, int row_first, int lane) {
    f32x4 gs[4], sv[4];
#pragma unroll
    for (int j = 0; j < 4; ++j) { const int c = 4 * lane + 256 * j; const f32x4 gg = *(const GAS f32x4*)(g + c), ss = *(const GAS f32x4*)(sc + c); gs[j] = gg * (ss + 1.0f); sv[j] = *(const GAS f32x4*)(sh + c); }
    for (int r = 0; r < 16; ++r) { const size_t row = (size_t)(row_first + r);
        const GAS f32x4* xr = (const GAS f32x4*)(h + row * D) + lane; f32x4 v[4]; float s = 0.f;
#pragma unroll
        for (int j = 0; j < 4; ++j) { v[j] = xr[64 * j]; s += (v[j].x * v[j].x + v[j].y * v[j].y) + (v[j].z * v[j].z + v[j].w * v[j].w); }
        const float rstd = 1.0f / sqrtf(wave_sum(s) * (1.0f / D) + EPS);
        GAS unsigned long long* o8 = (GAS unsigned long long*)(xn + row * D) + lane;
#pragma unroll
        for (int j = 0; j < 4; ++j) { const f32x4 y = v[j] * rstd * gs[j] + sv[j]; o8[64 * j] = (unsigned long long)pk2(y.x, y.y) | ((unsigned long long)pk2(y.z, y.w) << 32); } }
}

__global__ void __launch_bounds__(NWAVES * 64, 2) mk_fwd(Args args) {
    extern __shared__ __attribute__((aligned(16))) unsigned char lds_raw[];
    LAS unsigned char* lds = (LAS unsigned char*)lds_raw;
    volatile LAS unsigned* MISC = (volatile LAS unsigned*)(lds + MISC_OFF);
    const int tid = threadIdx.x, lane = tid & 63, wave = __builtin_amdgcn_readfirstlane(tid >> 6);
    const int G = gridDim.x;
    unsigned char* ws = args.ws;
    gu32* ctl = (gu32*)(ws + WS_CTL);
    float* modp = (float*)(ws + WS_MOD);
    bf16* Wb = (bf16*)(ws + WS_W);
    bf16* XN = (bf16*)(ws + WS_XN);
    float* hbuf = args.out;
    const float* x = args.in[0];
    for (int u = tid; u < (LDS_BYTES - LDSCTL_OFF) / 4; u += NWAVES * 64) ((LAS unsigned*)(lds + LDSCTL_OFF))[u] = 0u;
    __syncthreads();
    XcdBarrier bar; bar.bar = (unsigned*)(ctl + CW_BAR); bar.x = 0; bar.st = nullptr;
    if (N_LAUNCHES == 1) bar = xcd_barrier_post((unsigned*)(ctl + CW_BAR), MISC + 8);
    const int lo = args.ph_lo, hi = args.ph_hi;
#define IN(k) (lo <= (k) && (k) < hi)
#define SEAM(k) do { if (IN(k) && IN((k) + 1)) xcd_barrier(bar); } while (0)
    const int gw = blockIdx.x * NWAVES + wave, NGW = G * NWAVES;

    if (IN(0)) {
        LAS float* scr = (LAS float*)(lds + RING_OFF + wave * 16384);
        constexpr int I_GU = (D / 64) * (NGU / 32), I_D = (DFF / 64) * (D / 32), I_IN = (D / 64) * (NIN / 32), I_RO = (RV / 64) * (D / 32), I_SQ = (D / 64) * (D / 32);
        constexpr int NITEMS = 2 * I_GU + 2 * I_D + I_IN + I_RO + 2 * I_SQ;
        for (int it = gw; it < NITEMS; it += NGW) {
            int r = it;
            if (r < I_GU) { p0_transpose_item(args.in[6], D, NGU, Wb + WE_GU1, 1, scr, r, lane); continue; } r -= I_GU;
            if (r < I_D)  { p0_transpose_item(args.in[7], DFF, D, Wb + WE_D1, 0, scr, r, lane); continue; } r -= I_D;
            if (r < I_IN) { p0_transpose_item(args.in[9], D, NIN, Wb + WE_IN, 2, scr, r, lane); continue; } r -= I_IN;
            if (r < I_RO) { p0_transpose_item(args.in[12], RV, D, Wb + WE_RO, 0, scr, r, lane); continue; } r -= I_RO;
            if (r < I_SQ) { p0_transpose_item(args.in[17], D, D, Wb + WE_CO, 0, scr, r, lane); continue; } r -= I_SQ;
            if (r < I_SQ) { p0_transpose_item(args.in[19], D, D, Wb + WE_OUT, 0, scr, r, lane); continue; } r -= I_SQ;
            if (r < I_GU) { p0_transpose_item(args.in[21], D, NGU, Wb + WE_GU2, 1, scr, r, lane); continue; } r -= I_GU;
            p0_transpose_item(args.in[22], DFF, D, Wb + WE_D2, 0, scr, r, lane);
        }
        __syncthreads();
        LAS float* sc_l = (LAS float*)(lds + RING_OFF);
        const float* cin = args.in[1]; const float* wmod = args.in[3]; const float* bmod = args.in[4];
        for (int it = blockIdx.x; it < 18 * 16; it += G) {
            const int cb = it % 18, ks = it / 18, n = cb * 512 + tid, k0 = ks * 64;
            for (int e = tid; e < 16 * 64; e += NWAVES * 64) { const float cv = cin[(e >> 6) * D + k0 + (e & 63)]; sc_l[e] = cv / (1.0f + expf(-cv)); }
            __syncthreads();
            float a[16];
#pragma unroll
            for (int b = 0; b < 16; ++b) a[b] = (ks == 0) ? bmod[n] : 0.f;
            for (int k = 0; k < 64; ++k) { const float w = wmod[(size_t)(k0 + k) * NMOD + n];
#pragma unroll
                for (int b = 0; b < 16; ++b) a[b] += sc_l[b * 64 + k] * w; }
#pragma unroll
            for (int b = 0; b < 16; ++b) atomicAdd(modp + (size_t)b * NMOD + n, a[b]);
            __syncthreads();
        }
    }
    SEAM(0);
    if (IN(1)) { for (int r0 = gw * 16; r0 < M; r0 += NGW * 16) { const int b = r0 / SEQ; modnorm_rows(x, args.in[5], modp + (size_t)b * NMOD + 0 * D, modp + (size_t)b * NMOD + 1 * D, XN, r0, lane); } }
    SEAM(1);
    if (IN(2)) { pg8::Gemm g{XN, Wb + WE_GU1, M, NGU, D}; pg8::StaticOrder S; S.init(M, NGU, G, (int)blockIdx.x);
        pg8::EpiSwiGLU E{(bf16*)(ws + WS_ACT), DFF};
        pg8::gemm_phase<pg8::EpiSwiGLU, pg8::StaticOrder, PG8_ALIGN, PG8_SP2>(lds + RING_OFF, g, S, E); }
    SEAM(2);
    if (IN(3)) { pg8::Gemm g{(const bf16*)(ws + WS_ACT), Wb + WE_D1, M, D, DFF}; pg8::StaticOrder S; S.init(M, D, G, (int)blockIdx.x);
        pg8::EpiResid E{x, hbuf, modp + 2 * D, NMOD, 0.5f};
        pg8::gemm_phase<pg8::EpiResid, pg8::StaticOrder, PG8_ALIGN, PG8_SP2>(lds + RING_OFF, g, S, E); }
    SEAM(3);
    if (IN(4)) { for (int r0 = gw * 16; r0 < M; r0 += NGW * 16) { const int b = r0 / SEQ; modnorm_rows(hbuf, args.in[8], modp + (size_t)b * NMOD + 3 * D, modp + (size_t)b * NMOD + 4 * D, XN, r0, lane); } }
    SEAM(4);
    if (IN(5)) { pg8::Gemm g{XN, Wb + WE_IN + (size_t)6144 * D, M, 2048, D}; pg8::StaticOrder S; S.init(M, 2048, G, (int)blockIdx.x);
        pg8::EpiGLU E{(bf16*)(ws + WS_U), D};
        pg8::gemm_phase<pg8::EpiGLU, pg8::StaticOrder, PG8_ALIGN, PG8_SP2>(lds + RING_OFF, g, S, E); }
    SEAM(5);
    if (IN(6)) { conv_phase(lds + RING_OFF, (const bf16*)(ws + WS_U), args.in[13], args.in[14], args.in[15], args.in[16], (bf16*)(ws + WS_UC), tid, lane, wave, G); }
    SEAM(6);
    if (IN(7)) { pg8::Gemm g{XN, Wb + WE_IN, M, 4096, D}; pg8::StaticOrder S; S.init(M, 4096, G, (int)blockIdx.x);
        pg8::EpiQKV E{(bf16*)(ws + WS_Q), (bf16*)(ws + WS_K), (bf16*)(ws + WS_V), (const int*)args.in[2]};
        pg8::gemm_phase<pg8::EpiQKV, pg8::StaticOrder, PG8_ALIGN, PG8_SP2>(lds + RING_OFF, g, S, E); }
    SEAM(7);
    if (IN(8)) { retention_phase(lds + RING_OFF, (const bf16*)(ws + WS_Q), (const bf16*)(ws + WS_K), (bf16*)(ws + WS_V), tid, lane, wave, G); }
    SEAM(8);
    if (IN(9)) { pg8::Gemm g{XN, Wb + WE_IN + (size_t)4096 * D, M, 2048, D}; pg8::StaticOrder S; S.init(M, 2048, G, (int)blockIdx.x);
        pg8::EpiAct<1> E{(bf16*)(ws + WS_SG), RV};
        pg8::gemm_phase<pg8::EpiAct<1>, pg8::StaticOrder, PG8_ALIGN, PG8_SP2>(lds + RING_OFF, g, S, E); }
    SEAM(9);
    if (IN(10)) { gn_phase((bf16*)(ws + WS_V), (const bf16*)(ws + WS_SG), args.in[10], args.in[11], lane, gw, NGW); }
    SEAM(10);
    if (IN(11)) { pg8::Gemm g{XN, Wb + WE_IN + (size_t)8192 * D, M, 2048, D}; pg8::StaticOrder S; S.init(M, 2048, G, (int)blockIdx.x);
        pg8::EpiAct<2> E{(bf16*)(ws + WS_G2), 2048};
        pg8::gemm_phase<pg8::EpiAct<2>, pg8::StaticOrder, PG8_ALIGN, PG8_SP2>(lds + RING_OFF, g, S, E); }
    SEAM(11);
    if (IN(12)) { pg8::Gemm g{(const bf16*)(ws + WS_UC), Wb + WE_CO, M, D, D}; pg8::StaticOrder S; S.init(M, D, G, (int)blockIdx.x);
        pg8::EpiConvO E{(bf16*)(ws + WS_T), (const bf16*)(ws + WS_G2), args.in[18]};
        pg8::gemm_phase<pg8::EpiConvO, pg8::StaticOrder, PG8_ALIGN, PG8_SP2>(lds + RING_OFF, g, S, E); }
    SEAM(12);
    if (IN(13)) { pg8::Gemm g{(const bf16*)(ws + WS_V), Wb + WE_RO, M, D, RV}; pg8::StaticOrder S; S.init(M, D, G, (int)blockIdx.x);
        pg8::EpiRetO E{(bf16*)(ws + WS_T), (const bf16*)(ws + WS_G2)};
        pg8::gemm_phase<pg8::EpiRetO, pg8::StaticOrder, PG8_ALIGN, PG8_SP2>(lds + RING_OFF, g, S, E); }
    SEAM(13);
    if (IN(14)) { pg8::Gemm g{(const bf16*)(ws + WS_T), Wb + WE_OUT, M, D, D}; pg8::StaticOrder S; S.init(M, D, G, (int)blockIdx.x);
        pg8::EpiResid E{hbuf, hbuf, modp + 5 * D, NMOD, 1.0f};
        pg8::gemm_phase<pg8::EpiResid, pg8::StaticOrder, PG8_ALIGN, PG8_SP2>(lds + RING_OFF, g, S, E); }
    SEAM(14);
    if (IN(15)) { for (int r0 = gw * 16; r0 < M; r0 += NGW * 16) { const int b = r0 / SEQ; modnorm_rows(hbuf, args.in[20], modp + (size_t)b * NMOD + 6 * D, modp + (size_t)b * NMOD + 7 * D, XN, r0, lane); } }
    SEAM(15);
    if (IN(16)) { pg8::Gemm g{XN, Wb + WE_GU2, M, NGU, D}; pg8::StaticOrder S; S.init(M, NGU, G, (int)blockIdx.x);
        pg8::EpiSwiGLU E{(bf16*)(ws + WS_ACT), DFF};
        pg8::gemm_phase<pg8::EpiSwiGLU, pg8::StaticOrder, PG8_ALIGN, PG8_SP2>(lds + RING_OFF, g, S, E); }
    SEAM(16);
    if (IN(17)) { pg8::Gemm g{(const bf16*)(ws + WS_ACT), Wb + WE_D2, M, D, DFF}; pg8::StaticOrder S; S.init(M, D, G, (int)blockIdx.x);
        pg8::EpiResid E{hbuf, hbuf, modp + 8 * D, NMOD, 0.5f};
        pg8::gemm_phase<pg8::EpiResid, pg8::StaticOrder, PG8_ALIGN, PG8_SP2>(lds + RING_OFF, g, S, E); }
    SEAM(17);
    if (IN(18)) { for (int r0 = gw * 16; r0 < M; r0 += NGW * 16) {
        const float* gf = args.in[23]; f32x4 gs[4];
#pragma unroll
        for (int j = 0; j < 4; ++j) gs[j] = *(const GAS f32x4*)(gf + 4 * lane + 256 * j);
        for (int r = 0; r < 16; ++r) { GAS f32x4* xr = (GAS f32x4*)(hbuf + (size_t)(r0 + r) * D) + lane; f32x4 v[4]; float s = 0.f;
#pragma unroll
            for (int j = 0; j < 4; ++j) { v[j] = xr[64 * j]; s += (v[j].x * v[j].x + v[j].y * v[j].y) + (v[j].z * v[j].z + v[j].w * v[j].w); }
            const float rstd = 1.0f / sqrtf(wave_sum(s) * (1.0f / D) + EPS);
#pragma unroll
            for (int j = 0; j < 4; ++j) xr[64 * j] = v[j] * rstd * gs[j]; } } }
#undef IN
#undef SEAM
}


#if MK_CHECK
constexpr int NSAMP = 64;
constexpr size_t WS_CHK = 63 * MiB;
__device__ __forceinline__ int srow(int i) { switch (i) { case 0: return 0; case 1: return 1; case 2: return 29; case 3: return 30; case 4: return 31; case 5: return 127; case 6: return 128; case 7: return 255; case 8: return 2047; case 9: return 2048; case 10: return 2049; case 11: return 2078; case 12: return 4095; case 13: return 16384; case 14: return 32640; case 15: return 32767; default: return (i * 509 + 12345) & 32767; } }
__device__ __forceinline__ float b2f(bf16 v) { return __uint_as_float(((unsigned)v) << 16); }
__device__ __forceinline__ void upd(unsigned* res, int s, float err) { if (!(err == err)) err = 1e30f; atomicMax(res + s, __float_as_uint(err)); }
__device__ __forceinline__ float nerr(float got, float exp, float ta, float tr) { return fabsf(got - exp) / (ta + tr * fabsf(exp)); }
__device__ __forceinline__ float block_sum(float v, float* red) {
    v = wave_sum(v); __syncthreads(); if ((threadIdx.x & 63) == 0) red[threadIdx.x >> 6] = v; __syncthreads(); const float r = (red[0] + red[1]) + (red[2] + red[3]); __syncthreads(); return r; }
__device__ __forceinline__ float dsilu(float x) { return x / (1.0f + expf(-x)); }
__device__ __forceinline__ float dsig(float x) { return 1.0f / (1.0f + expf(-x)); }

__global__ void __launch_bounds__(256) k_check(Args args, int stage, int mode) {
    __shared__ float arow[2816]; __shared__ float red[4]; __shared__ float sc_s[2048];
    const int i = blockIdx.x, r = srow(i), b = r / SEQ, tid = threadIdx.x;
    unsigned char* ws = args.ws; unsigned* res = (unsigned*)(ws + WS_CTL) + 8192;
    const float* modp = (const float*)(ws + WS_MOD) + (size_t)b * NMOD; const bf16* Wb = (const bf16*)(ws + WS_W); const bf16* XN = (const bf16*)(ws + WS_XN);
    float* hbuf = args.out; float* EXP = (float*)(ws + WS_CHK) + (size_t)i * 2048;
    if (stage == 0) {
        const int bb = i & 15; const float* cin = args.in[1];
        for (int k = tid; k < D; k += 256) arow[k] = dsilu(cin[bb * D + k]);
        __syncthreads();
        const int n = tid * 36 + (i >> 4) * 9; float a = args.in[4][n];
        for (int k = 0; k < D; ++k) a += arow[k] * args.in[3][(size_t)k * NMOD + n];
        upd(res, 0, nerr(((const float*)(ws + WS_MOD))[(size_t)bb * NMOD + n], a, 2e-3f, 2e-3f));
        return;
    }
    if (stage == 1 || stage == 4 || stage == 15) {
        const float* src = stage == 1 ? args.in[0] : hbuf; const float* g = stage == 1 ? args.in[5] : stage == 4 ? args.in[8] : args.in[20];
        const int mo = stage == 1 ? 0 : stage == 4 ? 3 : 6; float s = 0.f;
        for (int k = tid; k < D; k += 256) { const float v = src[(size_t)r * D + k]; arow[k] = v; s += v * v; }
        const float rstd = 1.0f / sqrtf(block_sum(s, red) / D + EPS);
        for (int k = tid; k < D; k += 256) { const float e = arow[k] * rstd * g[k] * (1.0f + modp[(mo + 1) * D + k]) + modp[mo * D + k]; upd(res, stage, nerr(b2f(XN[(size_t)r * D + k]), e, 0.02f, 0.01f)); }
        return;
    }
    if (stage == 2 || stage == 16) {
        const float* w = args.in[stage == 2 ? 6 : 21]; const bf16* act = (const bf16*)(ws + WS_ACT);
        for (int k = tid; k < D; k += 256) arow[k] = b2f(XN[(size_t)r * D + k]);
        __syncthreads();
        for (int c = tid; c < DFF; c += 256) { float gsum = 0.f, usum = 0.f; for (int k = 0; k < D; ++k) { gsum += arow[k] * w[(size_t)k * NGU + c]; usum += arow[k] * w[(size_t)k * NGU + DFF + c]; }
            upd(res, stage, nerr(b2f(act[(size_t)r * DFF + c]), dsilu(gsum) * usum, 0.04f, 0.03f)); }
        return;
    }
    if (stage == 3 || stage == 17) {
        const float* w = args.in[stage == 3 ? 7 : 22]; const bf16* act = (const bf16*)(ws + WS_ACT); const float* gt = modp + (stage == 3 ? 2 : 8) * D;
        if (stage == 3 || mode == 1) {
            for (int k = tid; k < DFF; k += 256) arow[k] = b2f(act[(size_t)r * DFF + k]);
            __syncthreads();
            for (int c = tid; c < D; c += 256) { float s = 0.f; for (int k = 0; k < DFF; ++k) s += arow[k] * w[(size_t)k * D + c];
                const float base = stage == 3 ? args.in[0][(size_t)r * D + c] : hbuf[(size_t)r * D + c]; const float e = base + 0.5f * gt[c] * s;
                if (stage == 3) upd(res, 3, nerr(hbuf[(size_t)r * D + c], e, 0.02f, 0.01f)); else EXP[c] = e; }
        } else { for (int c = tid; c < D; c += 256) upd(res, 17, nerr(hbuf[(size_t)r * D + c], EXP[c], 0.02f, 0.01f)); }
        return;
    }
    if (stage == 5 || stage == 9 || stage == 11) {
        const float* w = args.in[9];
        for (int k = tid; k < D; k += 256) arow[k] = b2f(XN[(size_t)r * D + k]);
        __syncthreads();
        if (stage == 5) { const bf16* U = (const bf16*)(ws + WS_U);
            for (int c = tid; c < D; c += 256) { float a = 0.f, bb = 0.f; for (int k = 0; k < D; ++k) { a += arow[k] * w[(size_t)k * NIN + 6144 + c]; bb += arow[k] * w[(size_t)k * NIN + 7168 + c]; }
                upd(res, 5, nerr(b2f(U[(size_t)r * D + c]), a * dsig(bb), 0.03f, 0.02f)); } }
        else { const bf16* O = (const bf16*)(ws + (stage == 9 ? WS_SG : WS_G2)); const int co = stage == 9 ? 4096 : 8192;
            for (int c = tid; c < 2048; c += 256) { float a = 0.f; for (int k = 0; k < D; ++k) a += arow[k] * w[(size_t)k * NIN + co + c];
                upd(res, stage, nerr(b2f(O[(size_t)r * 2048 + c]), stage == 9 ? dsilu(a) : dsig(a), 0.03f, 0.02f)); } }
        return;
    }
    if (stage == 6) {
        const bf16* U = (const bf16*)(ws + WS_U); const bf16* UC = (const bf16*)(ws + WS_UC); const int s = r % SEQ; float cv[4]; float sum = 0.f;
        for (int q = 0; q < 4; ++q) { const int c = tid + 256 * q; float a = args.in[14][c];
            for (int t = 0; t < 31; ++t) { const int ss = s + t - 30; if (ss >= 0) a += args.in[13][t * D + c] * b2f(U[(size_t)(r + t - 30) * D + c]); }
            cv[q] = a; sum += a; }
        const float mean = block_sum(sum, red) / D; float q2 = 0.f;
        for (int q = 0; q < 4; ++q) q2 += (cv[q] - mean) * (cv[q] - mean);
        const float rstd = 1.0f / sqrtf(block_sum(q2, red) / D + EPS);
        for (int q = 0; q < 4; ++q) { const int c = tid + 256 * q; const float y = (cv[q] - mean) * rstd * args.in[15][c] + args.in[16][c]; upd(res, 6, nerr(b2f(UC[(size_t)r * D + c]), dsilu(y), 0.03f, 0.02f)); }
        return;
    }
    if (stage == 7) {
        const float* w = args.in[9]; const bf16* Qb = (const bf16*)(ws + WS_Q); const bf16* Kb = (const bf16*)(ws + WS_K); const bf16* Vb = (const bf16*)(ws + WS_V);
        for (int k = tid; k < D; k += 256) arow[k] = b2f(XN[(size_t)r * D + k]);
        __syncthreads();
        const float p = (float)((const int*)args.in[2])[r]; const int sl = r & 127;
        for (int c = tid; c < 2048; c += 256) {
            const int isk = c >= 1024, cc = c & 1023, h = cc >> 8, j = cc & 255, fi = j & 127, c1 = (isk ? 1024 : 0) + h * 256 + fi, c2 = c1 + 128;
            float x1 = 0.f, x2 = 0.f; for (int k = 0; k < D; ++k) { x1 += arow[k] * w[(size_t)k * NIN + c1]; x2 += arow[k] * w[(size_t)k * NIN + c2]; }
            const float fr = powf(10000.0f, -(float)fi * (2.0f / 256.0f)), ang = p * fr; float sn, cs; sincosf(ang, &sn, &cs);
            float o = (j < 128) ? (x1 * cs - x2 * sn) : (x1 * sn + x2 * cs);
            const float gam = 1.0f - exp2f(-5.0f - (float)h);
            o *= isk ? powf(gam, -(float)sl) * 0.0625f : powf(gam, (float)sl);
            upd(res, 7, nerr(b2f((isk ? Kb : Qb)[(size_t)r * 1024 + cc]), o, 0.03f * (isk ? powf(gam, -(float)sl) * 0.0625f : 1.0f) + 1e-4f, 0.03f)); }
        for (int c = tid; c < 2048; c += 256) { float a = 0.f; for (int k = 0; k < D; ++k) a += arow[k] * w[(size_t)k * NIN + 2048 + c]; upd(res, 7, nerr(b2f(Vb[(size_t)r * 2048 + c]), a, 0.03f, 0.02f)); }
        return;
    }
    if (stage == 8) {
        const bf16* Qb = (const bf16*)(ws + WS_Q); const bf16* Kb = (const bf16*)(ws + WS_K); const bf16* Vb = (const bf16*)(ws + WS_V); const int s = r % SEQ, rb = r - s;
        if (mode == 1) {
            for (int h = 0; h < 4; ++h) { const float gam = 1.0f - exp2f(-5.0f - (float)h), gC = powf(gam, 128.0f);
                __syncthreads();
                for (int k = tid; k < 256; k += 256) arow[k] = b2f(Qb[(size_t)r * 1024 + h * 256 + k]);
                __syncthreads();
                for (int m = tid; m <= s; m += 256) { float d = 0.f; for (int k = 0; k < 256; ++k) d += arow[k] * b2f(Kb[(size_t)(rb + m) * 1024 + h * 256 + k]); sc_s[m] = d * powf(gC, (float)((s >> 7) - (m >> 7))); }
                __syncthreads();
                for (int dcol = tid; dcol < 512; dcol += 256) { float a = 0.f; for (int m = 0; m <= s; ++m) a += sc_s[m] * b2f(Vb[(size_t)(rb + m) * 2048 + h * 512 + dcol]); EXP[h * 512 + dcol] = a; } }
        } else {
            for (int h = 0; h < 4; ++h) { float num = 0.f, den = 0.f; for (int dcol = tid; dcol < 512; dcol += 256) { const float e = EXP[h * 512 + dcol], g = b2f(Vb[(size_t)r * 2048 + h * 512 + dcol]); num += (g - e) * (g - e); den += e * e; }
                num = block_sum(num, red); den = block_sum(den, red); if (tid == 0) upd(res, 8, sqrtf(num / (den + 1e-20f)) / 0.03f); } }
        return;
    }
    if (stage == 10) {
        bf16* OY = (bf16*)(ws + WS_V); const bf16* SG = (const bf16*)(ws + WS_SG);
        if (mode == 1) { for (int h = 0; h < 4; ++h) { float v0 = b2f(OY[(size_t)r * 2048 + h * 512 + tid]), v1 = b2f(OY[(size_t)r * 2048 + h * 512 + 256 + tid]);
                const float mean = block_sum(v0 + v1, red) / 512.0f; const float var = block_sum((v0 - mean) * (v0 - mean) + (v1 - mean) * (v1 - mean), red) / 512.0f; const float rstd = 1.0f / sqrtf(var + EPS);
                for (int q = 0; q < 2; ++q) { const int c = h * 512 + q * 256 + tid; EXP[c] = (((q ? v1 : v0) - mean) * rstd * args.in[10][c] + args.in[11][c]) * b2f(SG[(size_t)r * 2048 + c]); } } }
        else { for (int c = tid; c < 2048; c += 256) upd(res, 10, nerr(b2f(OY[(size_t)r * 2048 + c]), EXP[c], 0.03f, 0.02f)); }
        return;
    }
    if (stage == 12) {
        const bf16* UC = (const bf16*)(ws + WS_UC); const bf16* G2 = (const bf16*)(ws + WS_G2); const bf16* T = (const bf16*)(ws + WS_T);
        for (int k = tid; k < D; k += 256) arow[k] = b2f(UC[(size_t)r * D + k]);
        __syncthreads();
        for (int c = tid; c < D; c += 256) { float a = args.in[18][c]; for (int k = 0; k < D; ++k) a += arow[k] * args.in[17][(size_t)k * D + c];
            upd(res, 12, nerr(b2f(T[(size_t)r * D + c]), a * b2f(G2[(size_t)r * 2048 + 1024 + c]), 0.03f, 0.02f)); }
        return;
    }
    if (stage == 13) {
        const bf16* Y = (const bf16*)(ws + WS_V); const bf16* G2 = (const bf16*)(ws + WS_G2); const bf16* T = (const bf16*)(ws + WS_T);
        if (mode == 1) { for (int k = tid; k < 2048; k += 256) sc_s[k] = b2f(Y[(size_t)r * 2048 + k]);
            __syncthreads();
            for (int c = tid; c < D; c += 256) { float a = 0.f; for (int k = 0; k < 2048; ++k) a += sc_s[k] * args.in[12][(size_t)k * D + c]; EXP[c] = b2f(T[(size_t)r * D + c]) + b2f(G2[(size_t)r * 2048 + c]) * a; } }
        else { for (int c = tid; c < D; c += 256) upd(res, 13, nerr(b2f(T[(size_t)r * D + c]), EXP[c], 0.03f, 0.02f)); }
        return;
    }
    if (stage == 14) {
        const bf16* T = (const bf16*)(ws + WS_T);
        if (mode == 1) { for (int k = tid; k < D; k += 256) arow[k] = b2f(T[(size_t)r * D + k]);
            __syncthreads();
            for (int c = tid; c < D; c += 256) { float a = 0.f; for (int k = 0; k < D; ++k) a += arow[k] * args.in[19][(size_t)k * D + c]; EXP[c] = hbuf[(size_t)r * D + c] + modp[5 * D + c] * a; } }
        else { for (int c = tid; c < D; c += 256) upd(res, 14, nerr(hbuf[(size_t)r * D + c], EXP[c], 0.02f, 0.01f)); }
        return;
    }
    if (stage == 18) {
        if (mode == 1) { float s = 0.f; for (int k = tid; k < D; k += 256) { const float v = hbuf[(size_t)r * D + k]; arow[k] = v; s += v * v; }
            const float rstd = 1.0f / sqrtf(block_sum(s, red) / D + EPS);
            for (int k = tid; k < D; k += 256) EXP[k] = arow[k] * rstd * args.in[23][k]; }
        else { for (int c = tid; c < D; c += 256) upd(res, 18, nerr(hbuf[(size_t)r * D + c], EXP[c], 1e-3f, 1e-3f)); }
        return;
    }
}
__global__ void k_apply(Args args) {
    const unsigned* res = (const unsigned*)(args.ws + WS_CTL) + 8192; int bad = -1;
    for (int s = 0; s < NPHASE; ++s) if (__uint_as_float(res[s]) > 1.0f) { bad = s; break; }
    if (bad < 0) return;
    const float c = 1.0f + 2.0f * powf(1.25f, (float)bad);
    for (size_t e = (size_t)blockIdx.x * blockDim.x + threadIdx.x; e < (size_t)M * D; e += (size_t)gridDim.x * blockDim.x) args.out[e] *= c;
}
#endif

extern "C" void kernel_launch(void* const* d_in, const int* in_sizes, int n_in, void* d_out, int out_size, void* d_ws, size_t ws_size, hipStream_t stream) {
    static int grid = 0;
    if (grid == 0) {
        if (n_in != 24 || in_sizes[0] != M * D || out_size != M * D || ws_size < WS_END) { fprintf(stderr, "kernel_launch: unexpected shapes (n_in %d, in0 %d, out %d, ws %zu); nothing launched\n", n_in, n_in > 0 ? in_sizes[0] : -1, out_size, ws_size); grid = -1; return; }
        int dev = 0, cus = 0, per_cu = 0;
        if (hipGetDevice(&dev) != hipSuccess || hipDeviceGetAttribute(&cus, hipDeviceAttributeMultiprocessorCount, dev) != hipSuccess) { grid = -1; return; }
        if (hipFuncSetAttribute((const void*)mk_fwd, hipFuncAttributeMaxDynamicSharedMemorySize, LDS_BYTES) != hipSuccess) { fprintf(stderr, "kernel_launch: hipFuncSetAttribute failed\n"); grid = -1; return; }
        if (hipOccupancyMaxActiveBlocksPerMultiprocessor(&per_cu, (const void*)mk_fwd, NWAVES * 64, LDS_BYTES) != hipSuccess || per_cu < 1)
            fprintf(stderr, "kernel_launch: note: occupancy query reports %d workgroups per CU\n", per_cu);
        (void)hipGetLastError();
        grid = cus;
    }
    if (grid < 0) return;
    if (hipMemsetAsync((char*)d_ws + WS_CTL, 0, CTL_ZERO_BYTES, stream) != hipSuccess) return;
    Args a{};
    for (int i = 0; i < 24; ++i) a.in[i] = (const float*)d_in[i];
    a.out = (float*)d_out; a.ws = (unsigned char*)d_ws;
    for (int li = 0; li < N_LAUNCHES; ++li) {
        a.ph_lo = (N_LAUNCHES == 1) ? 0 : li; a.ph_hi = (N_LAUNCHES == 1) ? NPHASE : li + 1; a.li = li; a.pad = 0;
#if MK_CHECK
        if (li == 8 || li == 10 || li == 13 || li == 14 || li == 17 || li == 18) hipLaunchKernelGGL(k_check, dim3(NSAMP), dim3(256), 0, stream, a, li, 1);
#endif
        hipLaunchKernelGGL(mk_fwd, dim3(grid), dim3(NWAVES * 64), LDS_BYTES, stream, a);
#if MK_CHECK
        hipLaunchKernelGGL(k_check, dim3(NSAMP), dim3(256), 0, stream, a, li, 0);
#endif
    }
#if MK_CHECK
    hipLaunchKernelGGL(k_apply, dim3(1024), dim3(256), 0, stream, a);
#endif
}
```

```cpp
#ifndef MK_OPAQUE_TID
#define MK_OPAQUE_TID 0
#endif
#ifndef MK_LAZYARGS
#define MK_LAZYARGS 0
#endif
#include <hip/hip_runtime.h>
#include <cstdio>
#include <cstdint>
namespace pg8 {
#define PG8_LAS __attribute__((address_space(3)))
typedef unsigned short bf16_t;
typedef short bf16x8 __attribute__((ext_vector_type(8)));
typedef float f32x4 __attribute__((ext_vector_type(4)));
typedef unsigned u32x4 __attribute__((ext_vector_type(4)));
constexpr int BM = 256, BK = 64, HALF = 128, HTB = HALF * BK * 2  , STAGE_BYTES = 8 * HTB, NXCD = 8, WGM = 8;

__host__ __device__ __forceinline__ int lds_byte(int r, int c) { const int st = (r >> 4) * 2 + (c >> 5), rr = r & 15, cc = c & 31, ob = rr * 64 + cc * 2; return st * 1024 + (ob ^ (((ob >> 9) & 1) << 5)); }
__host__ __device__ __forceinline__ void stage_rc(int b, int& R, int& C) { const int st = b / 1024, sb = b % 1024, swz = sb ^ (((sb >> 9) & 1) << 5); R = (st >> 1) * 16 + swz / 64; C = (st & 1) * 32 + (swz % 64) / 2; }
__host__ __device__ __forceinline__ int perm32(int rho) { const int n = rho >> 4, i = rho & 15; return 8 * (i >> 2) + 4 * n + (i & 3); }

struct Unit { int pm, pn; };
struct Gemm { const bf16_t* A; const bf16_t* Bt; int M, N, K; };

struct StaticOrder {
    int nM, nN, nwg, G, c;
    __host__ __device__ void init(int M, int N, int G_, int c_) { nM = M / BM; nN = N / BM; nwg = nM * nN; G = G_; c = c_; }
    __host__ __device__ bool next(int i, Unit& u) const {
        const long L = (long)i * G + c; if (L >= nwg) return false;
        int wgid = (int)L; { const int q = nwg / NXCD, r = nwg % NXCD, xcd = wgid % NXCD, off = wgid / NXCD; wgid = (xcd < r ? xcd * (q + 1) : r * (q + 1) + (xcd - r) * q) + off; }
        const int nig = WGM * nN, gid = wgid / nig, fm = gid * WGM, gsz = (nM - fm) < WGM ? (nM - fm) : WGM;
        u.pm = fm + ((wgid % nig) % gsz); u.pn = (wgid % nig) / gsz; return true;
    }
    __device__ __forceinline__ void a_ready(const Unit&) const {}
    __device__ __forceinline__ void done(const Unit&) const {}
};

__device__ __forceinline__ unsigned cvt_pk_bf16(float lo, float hi) { unsigned r; asm volatile("v_cvt_pk_bf16_f32 %0, %1, %2" : "=v"(r) : "v"(lo), "v"(hi)); return r; }
typedef float f32x2 __attribute__((ext_vector_type(2)));
typedef float f32x2 __attribute__((ext_vector_type(2)));
typedef unsigned u32x2 __attribute__((ext_vector_type(2)));
__device__ __forceinline__ float fast_sigmoid(float x) { return __builtin_amdgcn_rcpf(1.0f + __builtin_amdgcn_exp2f(-1.44269504089f * x)); }
__device__ __forceinline__ float fast_silu(float x) { return x * fast_sigmoid(x); }
typedef __bf16 bf16x2_c __attribute__((ext_vector_type(2)));
__device__ __forceinline__ unsigned cvt2(float lo, float hi) { f32x2 v = {lo, hi}; bf16x2_c b = __builtin_convertvector(v, bf16x2_c); return __builtin_bit_cast(unsigned, b); }
__device__ __forceinline__ u32x4 pack8(const f32x4 a, const f32x4 b) { u32x4 w; w.x = cvt2(a[0], a[1]); w.y = cvt2(a[2], a[3]); w.z = cvt2(b[0], b[1]); w.w = cvt2(b[2], b[3]); return w; }
__device__ __forceinline__ float bf_lo(unsigned w) { return __uint_as_float(w << 16); }
__device__ __forceinline__ float bf_hi(unsigned w) { return __uint_as_float(w & 0xffff0000u); }
__device__ __forceinline__ void unpack8(const u32x4 w, f32x4& a, f32x4& b) { a = (f32x4){bf_lo(w.x), bf_hi(w.x), bf_lo(w.y), bf_hi(w.y)}; b = (f32x4){bf_lo(w.z), bf_hi(w.z), bf_lo(w.w), bf_hi(w.w)}; }


__device__ __forceinline__ float row_rstd(const float* rss, int row) { return rsqrtf(rss[row] * (1.0f / 1024.0f) + 1e-6f); }
constexpr unsigned PG8_EC_OFF = 132096u, PG8_ECPM_OFF = 131072u + 320u + 64u;
struct EpiCache { const float* rss; const float* bias; int bstride; int N; };
#define PG8_EC ((PG8_LAS float*)PG8_EC_OFF)
#define PG8_ECPM ((volatile PG8_LAS unsigned*)PG8_ECPM_OFF)
#ifndef MK_EC
#define MK_EC 1
#endif
__device__ __forceinline__ void ec_sync(const EpiCache& c, const Unit& u, int tid) {
    if (MK_EC && *PG8_ECPM != (unsigned)u.pm) {
        asm volatile("s_waitcnt lgkmcnt(0)" ::: "memory"); __builtin_amdgcn_s_barrier(); asm volatile("" ::: "memory");
        if (tid < 256) PG8_EC[tid] = rsqrtf(c.rss[u.pm * BM + tid] * (1.0f / 1024.0f) + 1e-6f);
        const float* bp = c.bias + (size_t)(u.pm >> 3) * c.bstride;
        for (int e = tid * 4; e < c.N; e += 2048) *(PG8_LAS f32x4*)(PG8_EC + 256 + e) = *(const f32x4*)(bp + e);
        if (tid == 0) *PG8_ECPM = (unsigned)u.pm;
        asm volatile("s_waitcnt vmcnt(0) lgkmcnt(0)" ::: "memory"); __builtin_amdgcn_s_barrier(); asm volatile("" ::: "memory");
    }
}

template <bool NORM> struct EpiSwiGLU {
    static constexpr bool PERM = true, AFTER_DRAIN = false;
    bf16_t* O; int ldc; EpiCache c;
    __device__ __forceinline__ void operator()(const f32x4 (&acc)[2][2][4][2], const Unit& u, int wr, int wc, int fr, int fq) const {
        const int row0 = u.pm * BM + wr * 64 + fr, col0 = u.pn * HALF + wc * 32 + 8 * fq;
        f32x4 bv[2][2];
        if (NORM) { ec_sync(c, u, (wr * 4 + wc) * 64 + fq * 16 + fr); const float* bp = MK_EC ? (const float*)(PG8_EC + 256 + u.pn * BM + wc * 32 + 8 * fq) : c.bias + (size_t)(u.pm >> 3) * c.bstride + u.pn * BM + wc * 32 + 8 * fq;
#pragma unroll
            for (int bj = 0; bj < 2; ++bj)
#pragma unroll
                for (int n = 0; n < 2; ++n) bv[bj][n] = *(const f32x4*)(bp + bj * HALF + 4 * n); }
#pragma unroll
        for (int ai = 0; ai < 2; ++ai)
#pragma unroll
            for (int m = 0; m < 4; ++m) { const int row = row0 + ai * HALF + m * 16; bf16_t* rowp = O + (size_t)row * ldc + col0;
                const float rs = NORM ? (MK_EC ? PG8_EC[row - u.pm * BM] : row_rstd(c.rss, row)) : 1.0f;
                f32x4 v0, v1;
#pragma unroll
                for (int j = 0; j < 4; ++j) { float g0 = acc[ai][0][m][0][j], u0 = acc[ai][1][m][0][j], g1 = acc[ai][0][m][1][j], u1 = acc[ai][1][m][1][j];
                    if (NORM) { g0 = g0 * rs + bv[0][0][j]; u0 = u0 * rs + bv[1][0][j]; g1 = g1 * rs + bv[0][1][j]; u1 = u1 * rs + bv[1][1][j]; }
                    v0[j] = fast_silu(g0) * u0; v1[j] = fast_silu(g1) * u1; }
                *(u32x4*)rowp = pack8(v0, v1); }
    }
};
struct EpiQKVU {
    static constexpr bool PERM = true, AFTER_DRAIN = false;
    bf16_t* Q; bf16_t* Kb; bf16_t* V; bf16_t* U; const int* pos; EpiCache c;
    __device__ __forceinline__ void operator()(const f32x4 (&acc)[2][2][4][2], const Unit& u, int wr, int wc, int fr, int fq) const {
        const int row0 = u.pm * BM + wr * 64 + fr;
        f32x4 bv[2][2];
        ec_sync(c, u, (wr * 4 + wc) * 64 + fq * 16 + fr);
        { const float* bp = MK_EC ? (const float*)(PG8_EC + 256 + u.pn * BM + wc * 32 + 8 * fq) : c.bias + (size_t)(u.pm >> 3) * c.bstride + u.pn * BM + wc * 32 + 8 * fq;
#pragma unroll
          for (int bj = 0; bj < 2; ++bj)
#pragma unroll
              for (int n = 0; n < 2; ++n) bv[bj][n] = *(const f32x4*)(bp + bj * HALF + 4 * n); }
        if (u.pn >= 16) {
            const int col0 = (u.pn - 16) * HALF + wc * 32 + 8 * fq;
#pragma unroll
            for (int ai = 0; ai < 2; ++ai)
#pragma unroll
                for (int m = 0; m < 4; ++m) { const int row = row0 + ai * HALF + m * 16; const float rs = MK_EC ? PG8_EC[row - u.pm * BM] : row_rstd(c.rss, row); f32x4 v0, v1;
#pragma unroll
                    for (int j = 0; j < 4; ++j) { v0[j] = (acc[ai][0][m][0][j] * rs + bv[0][0][j]) * fast_sigmoid(acc[ai][1][m][0][j] * rs + bv[1][0][j]); v1[j] = (acc[ai][0][m][1][j] * rs + bv[0][1][j]) * fast_sigmoid(acc[ai][1][m][1][j] * rs + bv[1][1][j]); }
                    *(u32x4*)(U + (size_t)row * 1024 + col0) = pack8(v0, v1); }
            return;
        }
        if (u.pn >= 8) {
            const int col0 = (u.pn - 8) * BM + wc * 32 + 8 * fq;
#pragma unroll
            for (int ai = 0; ai < 2; ++ai)
#pragma unroll
                for (int m = 0; m < 4; ++m) { const int row = row0 + ai * HALF + m * 16; const float rs = MK_EC ? PG8_EC[row - u.pm * BM] : row_rstd(c.rss, row); bf16_t* rowp = V + (size_t)row * 2048 + col0;
#pragma unroll
                    for (int bj = 0; bj < 2; ++bj) *(u32x4*)(rowp + bj * HALF) = pack8(acc[ai][bj][m][0] * rs + bv[bj][0], acc[ai][bj][m][1] * rs + bv[bj][1]); }
            return;
        }
        const bool isk = u.pn >= 4; const int h = u.pn & 3;
        bf16_t* dst = (isk ? Kb : Q) + h * 256 + wc * 32 + 8 * fq;
        const float lg = __builtin_log2f(1.0f - __builtin_exp2f(-5.0f - (float)h));
        const int fi0 = wc * 32 + 8 * fq;
        float inv_freq[8];
#pragma unroll
        for (int j = 0; j < 8; ++j) inv_freq[j] = exp2f(-(float)(fi0 + j) * 0.10381025296523007f) * 0.15915494309189535f;
#pragma unroll
        for (int ai = 0; ai < 2; ++ai)
#pragma unroll
            for (int m = 0; m < 4; ++m) { const int row = row0 + ai * HALF + m * 16; const float p = (float)pos[row]; const float sl = (float)(row & 127); const float rs = MK_EC ? PG8_EC[row - u.pm * BM] : row_rstd(c.rss, row);
                const float dec = isk ? exp2f(-sl * lg) * 0.0625f : exp2f(sl * lg);
                f32x4 o1[2], o2[2];
#pragma unroll
                for (int n = 0; n < 2; ++n)
#pragma unroll
                    for (int j = 0; j < 4; ++j) { float t = p * inv_freq[4 * n + j]; t = t - floorf(t);
                        const float sn = __builtin_amdgcn_sinf(t), cs = __builtin_amdgcn_cosf(t);
                        const float x1 = acc[ai][0][m][n][j] * rs + bv[0][n][j], x2 = acc[ai][1][m][n][j] * rs + bv[1][n][j];
                        o1[n][j] = (x1 * cs - x2 * sn) * dec; o2[n][j] = (x1 * sn + x2 * cs) * dec; }
                bf16_t* rowp = dst + (size_t)row * 1024;
                *(u32x4*)rowp = pack8(o1[0], o1[1]); *(u32x4*)(rowp + HALF) = pack8(o2[0], o2[1]); }
    }
};
struct EpiYG {
    static constexpr bool PERM = true, AFTER_DRAIN = false;
    bf16_t* Y; bf16_t* G2; const float* st; const float* gng; const float* gnb; EpiCache c;
    __device__ __forceinline__ void operator()(const f32x4 (&acc)[2][2][4][2], const Unit& u, int wr, int wc, int fr, int fq) const {
        const int row0 = u.pm * BM + wr * 64 + fr;
        f32x4 bv[2][2];
        ec_sync(c, u, (wr * 4 + wc) * 64 + fq * 16 + fr);
        { const float* bp = MK_EC ? (const float*)(PG8_EC + 256 + u.pn * BM + wc * 32 + 8 * fq) : c.bias + (size_t)(u.pm >> 3) * c.bstride + u.pn * BM + wc * 32 + 8 * fq;
#pragma unroll
          for (int bj = 0; bj < 2; ++bj)
#pragma unroll
              for (int n = 0; n < 2; ++n) bv[bj][n] = *(const f32x4*)(bp + bj * HALF + 4 * n); }
        if (u.pn >= 8) {
            const int col0 = (u.pn - 8) * BM + wc * 32 + 8 * fq;
#pragma unroll
            for (int ai = 0; ai < 2; ++ai)
#pragma unroll
                for (int m = 0; m < 4; ++m) { const int row = row0 + ai * HALF + m * 16; const float rs = MK_EC ? PG8_EC[row - u.pm * BM] : row_rstd(c.rss, row); bf16_t* rowp = G2 + (size_t)row * 2048 + col0;
#pragma unroll
                    for (int bj = 0; bj < 2; ++bj) { f32x4 v0 = acc[ai][bj][m][0] * rs + bv[bj][0], v1 = acc[ai][bj][m][1] * rs + bv[bj][1];
#pragma unroll
                        for (int j = 0; j < 4; ++j) { v0[j] = fast_sigmoid(v0[j]); v1[j] = fast_sigmoid(v1[j]); }
                        *(u32x4*)(rowp + bj * HALF) = pack8(v0, v1); } }
            return;
        }
        const int col0 = u.pn * BM + wc * 32 + 8 * fq, head = u.pn >> 1;
        f32x4 gg[2][2], gb[2][2];
#pragma unroll
        for (int bj = 0; bj < 2; ++bj)
#pragma unroll
            for (int n = 0; n < 2; ++n) { gg[bj][n] = *(const f32x4*)(gng + col0 + bj * HALF + 4 * n); gb[bj][n] = *(const f32x4*)(gnb + col0 + bj * HALF + 4 * n); }
#pragma unroll
        for (int ai = 0; ai < 2; ++ai)
#pragma unroll
            for (int m = 0; m < 4; ++m) { const int row = row0 + ai * HALF + m * 16; const float rs = MK_EC ? PG8_EC[row - u.pm * BM] : row_rstd(c.rss, row);
                const f32x2 sq = *(const f32x2*)(st + ((size_t)head * 32768 + row) * 2);
                const float mean = sq.x * (1.0f / 512.0f); float var = sq.y * (1.0f / 512.0f) - mean * mean; var = var < 0.f ? 0.f : var; const float grs = rsqrtf(var + 1e-6f);
                bf16_t* rowp = Y + (size_t)row * 2048 + col0;
#pragma unroll
                for (int bj = 0; bj < 2; ++bj) { f32x4 o0, o1; unpack8(*(const u32x4*)(rowp + bj * HALF), o0, o1);
                    f32x4 z0 = acc[ai][bj][m][0] * rs + bv[bj][0], z1 = acc[ai][bj][m][1] * rs + bv[bj][1];
#pragma unroll
                    for (int j = 0; j < 4; ++j) { z0[j] = fast_silu(z0[j]); z1[j] = fast_silu(z1[j]); }
                    *(u32x4*)(rowp + bj * HALF) = pack8(((o0 - mean) * grs * gg[bj][0] + gb[bj][0]) * z0, ((o1 - mean) * grs * gg[bj][1] + gb[bj][1]) * z1); } }
    }
};
template <bool BASEBF> struct EpiResNorm {
    static constexpr bool PERM = true, AFTER_DRAIN = false;
    const void* base; bf16_t* H; bf16_t* XNo; float* rss; const float* gate; const float* g; const float* sc; int gs; float scale;
    __device__ __forceinline__ void operator()(const f32x4 (&acc)[2][2][4][2], const Unit& u, int wr, int wc, int fr, int fq) const {
        const int row0 = u.pm * BM + wr * 64 + fr, col0 = u.pn * BM + wc * 32 + 8 * fq; const size_t bo = (size_t)(u.pm >> 3) * gs + col0;
        f32x4 gv[2][2], gsv[2][2];
#pragma unroll
        for (int bj = 0; bj < 2; ++bj)
#pragma unroll
            for (int n = 0; n < 2; ++n) { gv[bj][n] = *(const f32x4*)(gate + bo + bj * HALF + 4 * n) * scale; gsv[bj][n] = *(const f32x4*)(g + col0 + bj * HALF + 4 * n) * (*(const f32x4*)(sc + bo + bj * HALF + 4 * n) + 1.0f); }
#pragma unroll
        for (int ai = 0; ai < 2; ++ai)
#pragma unroll
            for (int m = 0; m < 4; ++m) { const int row = row0 + ai * HALF + m * 16; const size_t off = (size_t)row * 1024 + col0; float ss = 0.f;
#pragma unroll
                for (int bj = 0; bj < 2; ++bj) { f32x4 b0, b1;
                    if (BASEBF) unpack8(*(const u32x4*)((const bf16_t*)base + off + bj * HALF), b0, b1);
                    else { b0 = *(const f32x4*)((const float*)base + off + bj * HALF); b1 = *(const f32x4*)((const float*)base + off + bj * HALF + 4); }
                    const f32x4 h0 = b0 + gv[bj][0] * acc[ai][bj][m][0], h1 = b1 + gv[bj][1] * acc[ai][bj][m][1];
                    ss += (h0[0] * h0[0] + h0[1] * h0[1]) + (h0[2] * h0[2] + h0[3] * h0[3]) + (h1[0] * h1[0] + h1[1] * h1[1]) + (h1[2] * h1[2] + h1[3] * h1[3]);
                    *(u32x4*)(H + off + bj * HALF) = pack8(h0, h1); *(u32x4*)(XNo + off + bj * HALF) = pack8(h0 * gsv[bj][0], h1 * gsv[bj][1]); }
                ss += __shfl_xor(ss, 16); ss += __shfl_xor(ss, 32);
                if (fq == 0) atomicAdd(rss + row, ss); }
    }
};
struct EpiResidOut {
    static constexpr bool PERM = false, AFTER_DRAIN = false;
    const bf16_t* base; float* out; const float* gate; int gs; float scale;
    __device__ __forceinline__ void operator()(const f32x4 (&acc)[2][2][4][2], const Unit& u, int wr, int wc, int fr, int fq) const {
        const int row0 = u.pm * BM + wr * 64 + fr, col0 = u.pn * BM + wc * 32 + 4 * fq;
        const float* gp = gate + (size_t)(u.pm >> 3) * gs + col0;
        f32x4 gv[2][2];
#pragma unroll
        for (int bj = 0; bj < 2; ++bj)
#pragma unroll
            for (int n = 0; n < 2; ++n) gv[bj][n] = *(const f32x4*)(gp + bj * HALF + n * 16) * scale;
#pragma unroll
        for (int ai = 0; ai < 2; ++ai)
#pragma unroll
            for (int m = 0; m < 4; ++m) { const size_t off = (size_t)(row0 + ai * HALF + m * 16) * 1024 + col0;
#pragma unroll
                for (int bj = 0; bj < 2; ++bj)
#pragma unroll
                    for (int n = 0; n < 2; ++n) { const u32x2 w = *(const u32x2*)(base + off + bj * HALF + n * 16); const f32x4 bs = (f32x4){bf_lo(w.x), bf_hi(w.x), bf_lo(w.y), bf_hi(w.y)};
                        *(f32x4*)(out + off + bj * HALF + n * 16) = bs + gv[bj][n] * acc[ai][bj][m][n]; } }
    }
};
struct EpiConvO {
    static constexpr bool PERM = true, AFTER_DRAIN = false;
    bf16_t* T; const bf16_t* G; const float* bias;
    __device__ __forceinline__ void operator()(const f32x4 (&acc)[2][2][4][2], const Unit& u, int wr, int wc, int fr, int fq) const {
        const int row0 = u.pm * BM + wr * 64 + fr, col0 = u.pn * BM + wc * 32 + 8 * fq;
        f32x4 bv[2][2];
#pragma unroll
        for (int bj = 0; bj < 2; ++bj)
#pragma unroll
            for (int n = 0; n < 2; ++n) bv[bj][n] = *(const f32x4*)(bias + col0 + bj * HALF + 4 * n);
#pragma unroll
        for (int ai = 0; ai < 2; ++ai)
#pragma unroll
            for (int m = 0; m < 4; ++m) { const size_t row = (size_t)(row0 + ai * HALF + m * 16);
#pragma unroll
                for (int bj = 0; bj < 2; ++bj) { f32x4 g0, g1; unpack8(*(const u32x4*)(G + row * 2048 + 1024 + col0 + bj * HALF), g0, g1);
                    *(u32x4*)(T + row * 1024 + col0 + bj * HALF) = pack8(g0 * (acc[ai][bj][m][0] + bv[bj][0]), g1 * (acc[ai][bj][m][1] + bv[bj][1])); } }
    }
};
struct EpiRetO {
    static constexpr bool PERM = true, AFTER_DRAIN = false;
    bf16_t* T; const bf16_t* G;
    __device__ __forceinline__ void operator()(const f32x4 (&acc)[2][2][4][2], const Unit& u, int wr, int wc, int fr, int fq) const {
        const int row0 = u.pm * BM + wr * 64 + fr, col0 = u.pn * BM + wc * 32 + 8 * fq;
#pragma unroll
        for (int ai = 0; ai < 2; ++ai)
#pragma unroll
            for (int m = 0; m < 4; ++m) { const size_t row = (size_t)(row0 + ai * HALF + m * 16);
#pragma unroll
                for (int bj = 0; bj < 2; ++bj) { f32x4 g0, g1, t0, t1; unpack8(*(const u32x4*)(G + row * 2048 + col0 + bj * HALF), g0, g1); unpack8(*(const u32x4*)(T + row * 1024 + col0 + bj * HALF), t0, t1);
                    *(u32x4*)(T + row * 1024 + col0 + bj * HALF) = pack8(t0 + g0 * acc[ai][bj][m][0], t1 + g1 * acc[ai][bj][m][1]); } }
    }
};

template <class Epi, class Sched, bool ALIGN_EPI = false, bool SP2 = false, bool TIMED = false>
__device__ __forceinline__ void gemm_phase(PG8_LAS unsigned char* lds, const Gemm g, const Sched& S, const Epi& E, unsigned long long* tmr = nullptr) {
    unsigned long long tK = 0, tE = 0, tm0 = 0;
    int tid_ = threadIdx.x;
#if MK_OPAQUE_TID
    asm volatile("" : "+v"(tid_));
#endif
    const int tid = tid_, wid = __builtin_amdgcn_readfirstlane(tid >> 6), lane = tid & 63, wr = wid >> 2, wc = wid & 3, fr = lane & 15, fq = lane >> 4;
    const int K = g.K, nt = K / BK;
    unsigned voffA[2], voffB[2];
#pragma unroll
    for (int i = 0; i < 2; ++i) { int R, C; stage_rc(tid * 16 + i * 8192, R, C); const int Rb = Epi::PERM ? ((R & ~31) + perm32(R & 31)) : R;
        voffA[i] = (unsigned)(R * K + C) * 2u; voffB[i] = (unsigned)(Rb * K + C) * 2u; }
    const size_t kstep = (size_t)(BK * 2);
    const size_t hstep = (size_t)HALF * K * 2;
    const size_t tstep = 2 * hstep;
    const unsigned ldsw = (unsigned)wid * 1024u;
    const int aoff = lds_byte(wr * 64 + fr, fq * 8), boff = lds_byte(wc * 32 + fr, fq * 8);
#define PG8_SA(b, h) (((b) * 2 + (h)) * HTB)
#define PG8_SB(b, h) ((4 + (b) * 2 + (h)) * HTB)
#define PG8_STAGE(bufoff, gbase, voff) do { _Pragma("unroll") for (int _i = 0; _i < 2; ++_i) \
        __builtin_amdgcn_global_load_lds((const unsigned*)((const char*)(gbase) + (voff)[_i]), (PG8_LAS unsigned*)(lds + (bufoff) + ldsw + _i * 8192), 16, 0, 0); } while (0)
#define PG8_LDA(dst, b, h) do { _Pragma("unroll") for (int m = 0; m < 4; ++m) _Pragma("unroll") for (int k = 0; k < 2; ++k) dst[m][k] = *(const PG8_LAS bf16x8*)(lds + PG8_SA(b, h) + aoff + m * 2048 + k * 1024); } while (0)
#define PG8_LDB(dst, b, h) do { _Pragma("unroll") for (int n = 0; n < 2; ++n) _Pragma("unroll") for (int k = 0; k < 2; ++k) dst[n][k] = *(const PG8_LAS bf16x8*)(lds + PG8_SB(b, h) + boff + n * 2048 + k * 1024); } while (0)
#define PG8_MMA(ai, bj, At, Bt) do { __builtin_amdgcn_s_setprio(1); _Pragma("unroll") for (int m = 0; m < 4; ++m) _Pragma("unroll") for (int n = 0; n < 2; ++n) _Pragma("unroll") for (int k = 0; k < 2; ++k) \
        acc[ai][bj][m][n] = __builtin_amdgcn_mfma_f32_16x16x32_bf16(Bt[n][k], At[m][k], acc[ai][bj][m][n], 0, 0, 0); __builtin_amdgcn_s_setprio(0); } while (0)
#define PG8_WAIT_V(n) asm volatile("s_waitcnt vmcnt(" #n ")" ::: "memory")
#define PG8_WAIT_L(n) asm volatile("s_waitcnt lgkmcnt(" #n ")" ::: "memory")
#define PG8_BAR __builtin_amdgcn_s_barrier()
#define PG8_SCHED __builtin_amdgcn_sched_barrier(0)
    Unit cur, nxt; int ui = 0;
    if (!S.next(0, cur)) return;
    f32x4 acc[2][2][4][2];
#pragma unroll
    for (int a = 0; a < 2; ++a)
#pragma unroll
        for (int b = 0; b < 2; ++b)
#pragma unroll
            for (int m = 0; m < 4; ++m)
#pragma unroll
                for (int n = 0; n < 2; ++n) acc[a][b][m][n] = (f32x4){0.f, 0.f, 0.f, 0.f};
    bf16x8 At[4][2], B0[2][2], B1[2][2];
    const char* cA = (const char*)g.A + (size_t)cur.pm * tstep; const char* cB = (const char*)g.Bt + (size_t)cur.pn * tstep;
    S.a_ready(cur);
    if constexpr (SP2) {
        PG8_STAGE(PG8_SB(0, 0), cB, voffB); PG8_STAGE(PG8_SB(0, 1), cB + hstep, voffB); PG8_STAGE(PG8_SA(0, 0), cA, voffA); PG8_STAGE(PG8_SA(0, 1), cA + hstep, voffA);
        if (wr == 1) PG8_BAR;
        PG8_WAIT_V(2); PG8_BAR;
        PG8_STAGE(PG8_SB(1, 0), cB + kstep, voffB); PG8_STAGE(PG8_SA(1, 0), cA + kstep, voffA); PG8_STAGE(PG8_SB(1, 1), cB + hstep + kstep, voffB);
        PG8_WAIT_V(6); PG8_BAR;
    } else {
        PG8_STAGE(PG8_SB(0, 0), cB, voffB); PG8_STAGE(PG8_SA(0, 0), cA, voffA); PG8_STAGE(PG8_SB(0, 1), cB + hstep, voffB); PG8_STAGE(PG8_SA(0, 1), cA + hstep, voffA);
        if (wr == 1) PG8_BAR;
        PG8_WAIT_V(4); PG8_BAR;
        PG8_STAGE(PG8_SB(1, 0), cB + kstep, voffB); PG8_STAGE(PG8_SA(1, 0), cA + kstep, voffA); PG8_STAGE(PG8_SB(1, 1), cB + hstep + kstep, voffB);
        PG8_WAIT_V(6); PG8_BAR;
    }
    for (;;) {
        const bool has_next = S.next(ui + 1, nxt);
        if (TIMED) tm0 = __builtin_readcyclecounter();
        const char* nA = has_next ? (const char*)g.A + (size_t)nxt.pm * tstep : cA; const char* nB = has_next ? (const char*)g.Bt + (size_t)nxt.pn * tstep : cB;
        for (int t = 0; t < nt; t += 2) {
            const bool last = (t == nt - 2);
            const char* a1 = cA + (size_t)(t + 1) * kstep;
            const char* a2 = last ? nA : cA + (size_t)(t + 2) * kstep; const char* b2 = last ? nB : cB + (size_t)(t + 2) * kstep;
            const char* a3 = a2 + kstep; const char* b3 = b2 + kstep;
            if (last && has_next) S.a_ready(nxt);
            if constexpr (SP2) {
            PG8_LDB(B0, 0, 0); PG8_LDB(B1, 0, 1); PG8_SCHED; PG8_LDA(At, 0, 0); PG8_STAGE(PG8_SA(1, 1), a1 + hstep, voffA);
            PG8_WAIT_V(8); PG8_WAIT_L(0); PG8_BAR; PG8_MMA(0, 0, At, B0); PG8_MMA(0, 1, At, B1); PG8_BAR; PG8_SCHED;
            PG8_LDA(At, 0, 1); PG8_STAGE(PG8_SB(0, 0), b2, voffB); PG8_STAGE(PG8_SB(0, 1), b2 + hstep, voffB); PG8_STAGE(PG8_SA(0, 0), a2, voffA);
            PG8_WAIT_V(8); PG8_WAIT_L(0); PG8_BAR; PG8_MMA(1, 0, At, B0); PG8_MMA(1, 1, At, B1); PG8_BAR; PG8_SCHED;
            PG8_LDB(B0, 1, 0); PG8_LDB(B1, 1, 1); PG8_SCHED; PG8_LDA(At, 1, 0); PG8_STAGE(PG8_SA(0, 1), a2 + hstep, voffA);
            PG8_WAIT_V(8); PG8_WAIT_L(0); PG8_BAR; PG8_MMA(0, 0, At, B0); PG8_MMA(0, 1, At, B1); PG8_BAR; PG8_SCHED;
            PG8_LDA(At, 1, 1); PG8_STAGE(PG8_SB(1, 0), b3, voffB); PG8_STAGE(PG8_SB(1, 1), b3 + hstep, voffB); PG8_STAGE(PG8_SA(1, 0), a3, voffA);
            PG8_WAIT_V(8); PG8_WAIT_L(0); PG8_BAR; PG8_MMA(1, 0, At, B0); PG8_MMA(1, 1, At, B1); PG8_BAR; PG8_SCHED;
            } else {
            PG8_LDB(B0, 0, 0); PG8_SCHED; PG8_LDA(At, 0, 0); PG8_STAGE(PG8_SA(1, 1), a1 + hstep, voffA);
            PG8_WAIT_L(8); PG8_BAR; PG8_WAIT_L(0); PG8_MMA(0, 0, At, B0); PG8_BAR; PG8_SCHED;
            PG8_LDB(B1, 0, 1); PG8_STAGE(PG8_SB(0, 0), b2, voffB);
            PG8_BAR; PG8_WAIT_L(0); PG8_MMA(0, 1, At, B1); PG8_BAR;
            PG8_LDA(At, 0, 1); PG8_STAGE(PG8_SA(0, 0), a2, voffA);
            PG8_BAR; PG8_WAIT_L(0); PG8_MMA(1, 0, At, B0); PG8_BAR; PG8_SCHED;
            PG8_STAGE(PG8_SB(0, 1), b2 + hstep, voffB);
            PG8_WAIT_V(6); PG8_BAR; PG8_MMA(1, 1, At, B1); PG8_BAR;
            PG8_LDB(B0, 1, 0); PG8_SCHED; PG8_LDA(At, 1, 0); PG8_STAGE(PG8_SA(0, 1), a2 + hstep, voffA);
            PG8_WAIT_L(8); PG8_BAR; PG8_WAIT_L(0); PG8_MMA(0, 0, At, B0); PG8_BAR; PG8_SCHED;
            PG8_LDB(B1, 1, 1); PG8_STAGE(PG8_SB(1, 0), b3, voffB);
            PG8_BAR; PG8_WAIT_L(0); PG8_MMA(0, 1, At, B1); PG8_BAR;
            PG8_LDA(At, 1, 1); PG8_STAGE(PG8_SA(1, 0), a3, voffA);
            PG8_BAR; PG8_WAIT_L(0); PG8_MMA(1, 0, At, B0); PG8_BAR; PG8_SCHED;
            PG8_STAGE(PG8_SB(1, 1), b3 + hstep, voffB);
            PG8_WAIT_V(6); PG8_BAR; PG8_MMA(1, 1, At, B1); PG8_BAR;
            }
        }
        if (TIMED) { const unsigned long long t1 = __builtin_readcyclecounter(); tK += t1 - tm0; tm0 = t1; }
        if constexpr (ALIGN_EPI) { if (wr == 0) PG8_BAR; }
        if constexpr (!Epi::AFTER_DRAIN) { E(acc, cur, wr, wc, fr, fq); S.done(cur); }
        if (TIMED) { const unsigned long long t2 = __builtin_readcyclecounter(); tE += t2 - tm0; }
        if (!has_next) break;
#pragma unroll
        for (int a = 0; a < 2; ++a)
#pragma unroll
            for (int b = 0; b < 2; ++b)
#pragma unroll
                for (int m = 0; m < 4; ++m)
#pragma unroll
                    for (int n = 0; n < 2; ++n) acc[a][b][m][n] = (f32x4){0.f, 0.f, 0.f, 0.f};
        cur = nxt; cA = nA; cB = nB; ++ui;
        if constexpr (ALIGN_EPI) { if (wr == 1) PG8_BAR; }
    }
    if (TIMED && blockIdx.x == 0 && tid == 0) { tmr[0] = tK; tmr[1] = tE; }
    PG8_WAIT_V(0);
    if constexpr (!ALIGN_EPI) { if (wr == 0) PG8_BAR; }
    PG8_BAR;
    if constexpr (Epi::AFTER_DRAIN) { E.fused(acc, cur, wr, wc, fr, fq, lds, wid, lane); S.done(cur); }
#undef PG8_SA
#undef PG8_SB
#undef PG8_STAGE
#undef PG8_LDA
#undef PG8_LDB
#undef PG8_MMA
#undef PG8_WAIT_V
#undef PG8_WAIT_L
#undef PG8_BAR
#undef PG8_SCHED
}
}
#define GAS __attribute__((address_space(1)))
#define LAS __attribute__((address_space(3)))
typedef unsigned short bf16;
typedef unsigned v4u __attribute__((ext_vector_type(4)));
typedef float f32x4 __attribute__((ext_vector_type(4)));
typedef short bf16x8 __attribute__((ext_vector_type(8)));
typedef GAS unsigned gu32;
typedef GAS unsigned long long gu64;
#define RLX_AGENT __ATOMIC_RELAXED, __HIP_MEMORY_SCOPE_AGENT
#define LDS_WAIT() asm volatile("s_waitcnt lgkmcnt(0)" ::: "memory")
#define VM_WAIT() asm volatile("s_waitcnt vmcnt(0)" ::: "memory")
__device__ __forceinline__ unsigned long long rt() { return __builtin_amdgcn_s_memrealtime(); }
__device__ __forceinline__ unsigned f2bf(float f) { unsigned u = __builtin_bit_cast(unsigned, f); return (u + 0x7fffu + ((u >> 16) & 1u)) >> 16; }
__device__ __forceinline__ unsigned pk2(float lo, float hi) { return f2bf(lo) | (f2bf(hi) << 16); }

#define XB_TMO      128
#define XB_XCNT(j)  (256  + 64 * (j))
#define XB_XSUB(j)  (1280 + 64 * (j))
#define XB_XGEN(j)  (2304 + 64 * (j))
#define XB_TOP      3328
#define XB_TOPGEN   3392
#define XCD_BAR_WORDS 3456
#define XB_SPIN_CAP (1u << 18)

__device__ __forceinline__ unsigned xb_ld(unsigned* p)              { return __hip_atomic_load(p, __ATOMIC_RELAXED, __HIP_MEMORY_SCOPE_AGENT); }
__device__ __forceinline__ unsigned xb_add(unsigned* p, unsigned v) { return __hip_atomic_fetch_add(p, v, __ATOMIC_RELAXED, __HIP_MEMORY_SCOPE_AGENT); }
__device__ __forceinline__ unsigned xb_xcc_id() { return (unsigned)__builtin_amdgcn_s_getreg((3 << 11) | 20) & 0xFu; }
#define XB_SPIN(cond, bar) do { unsigned _sp = 0; while (cond) { __builtin_amdgcn_s_sleep(1); \
    if ((++_sp & 255u) == 0u) { if (xb_ld(&(bar)[XB_TMO])) break; if (_sp > XB_SPIN_CAP) { atomicAdd(&(bar)[XB_TMO], 1u); break; } } } } while (0)

struct XcdBarrier {
    unsigned* bar; unsigned x;
    volatile LAS unsigned* st;
};

__device__ __forceinline__ XcdBarrier xcd_barrier_post(unsigned* bar, volatile LAS unsigned* st) {
    XcdBarrier b; b.bar = bar; b.x = xb_xcc_id(); b.st = st;
    if (threadIdx.x == 0) (void)xb_add(&bar[XB_XCNT(b.x)], 1u);
    return b;
}
__device__ __forceinline__ void xcd_barrier_complete(unsigned* bar, unsigned x, unsigned& nloc, unsigned& nx) {
    const unsigned G = gridDim.x * gridDim.y * gridDim.z;
    unsigned sum, cnt, mine, sp = 0u;
    for (;;) {
        sum = 0u; cnt = 0u; mine = 0u;
#pragma unroll
        for (unsigned j = 0; j < 16; ++j) { const unsigned c = xb_ld(&bar[XB_XCNT(j)]); sum += c; cnt += (c > 0u) ? 1u : 0u; mine = (j == x) ? c : mine; }
        if (sum == G) break;
        __builtin_amdgcn_s_sleep(1);
        if ((++sp & 255u) == 0u) { if (xb_ld(&bar[XB_TMO])) break; if (sp > XB_SPIN_CAP) { atomicAdd(&bar[XB_TMO], 1u); break; } }
    }
    nloc = mine > 0u ? mine : 1u; nx = cnt > 0u ? cnt : 1u;
}

__device__ __forceinline__ void xcd_barrier(const XcdBarrier& b) {
    asm volatile("s_waitcnt vmcnt(0)" ::: "memory");
    __syncthreads();
    if (threadIdx.x == 0) {
        unsigned* bar = b.bar;
        __builtin_amdgcn_s_waitcnt(0);
        unsigned nloc = b.st[0], nx = b.st[1];
        if (nloc == 0u) { xcd_barrier_complete(bar, b.x, nloc, nx); b.st[0] = nloc; b.st[1] = nx; }
        const unsigned old = xb_add(&bar[XB_XSUB(b.x)], 1u);
        const unsigned gen = old / nloc;
        if (old + 1u == (gen + 1u) * nloc) {
            __builtin_amdgcn_fence(__ATOMIC_RELEASE, "agent");
            asm volatile("s_waitcnt vmcnt(0)" ::: "memory");
            const unsigned og = xb_add(&bar[XB_TOP], 1u);
            const unsigned tg = og / nx;
            if (og + 1u == (tg + 1u) * nx) xb_add(&bar[XB_TOPGEN], 1u);
            else XB_SPIN(xb_ld(&bar[XB_TOPGEN]) == tg, bar);
            __builtin_amdgcn_fence(__ATOMIC_ACQUIRE, "agent");
            xb_add(&bar[XB_XGEN(b.x)], 1u);
            asm volatile("s_waitcnt vmcnt(0)" ::: "memory");
        } else {
            XB_SPIN(xb_ld(&bar[XB_XGEN(b.x)]) == gen, bar);
            __builtin_amdgcn_fence(__ATOMIC_ACQUIRE, "agent");
            asm volatile("s_waitcnt vmcnt(0)" ::: "memory");
        }
    }
    __syncthreads();
}

__device__ __forceinline__ float wave_sum(float v) {
    v += __builtin_bit_cast(float, __builtin_amdgcn_update_dpp(0, __builtin_bit_cast(int, v), 0xB1, 0xf, 0xf, true));
    v += __builtin_bit_cast(float, __builtin_amdgcn_update_dpp(0, __builtin_bit_cast(int, v), 0x4E, 0xf, 0xf, true));
    v += __builtin_bit_cast(float, __builtin_amdgcn_update_dpp(0, __builtin_bit_cast(int, v), 0x141, 0xf, 0xf, true));
    v += __builtin_bit_cast(float, __builtin_amdgcn_update_dpp(0, __builtin_bit_cast(int, v), 0x140, 0xf, 0xf, true));
    const int iv = __builtin_bit_cast(int, v);
    return (__builtin_bit_cast(float, __builtin_amdgcn_readlane(iv, 0)) + __builtin_bit_cast(float, __builtin_amdgcn_readlane(iv, 16))) + (__builtin_bit_cast(float, __builtin_amdgcn_readlane(iv, 32)) + __builtin_bit_cast(float, __builtin_amdgcn_readlane(iv, 48)));
}
__device__ __forceinline__ float bfl(unsigned w) { return __uint_as_float(w << 16); }
__device__ __forceinline__ float bfh(unsigned w) { return __uint_as_float(w & 0xffff0000u); }
__device__ __forceinline__ float sigm(float x) { return __builtin_amdgcn_rcpf(1.0f + __builtin_amdgcn_exp2f(-1.44269504089f * x)); }

__device__ __forceinline__ void gn_phase(bf16* OY, const bf16* SG, const float* gg, const float* gb, int lane, int gw, int NGW) {
    for (int tb = gw; tb < (32768 / 64) * 4; tb += NGW) {
        const int h = tb & 3, t0 = (tb >> 2) * 64, c0 = h * 512 + 8 * lane;
        const f32x4 g0 = *(const GAS f32x4*)(gg + c0), g1 = *(const GAS f32x4*)(gg + c0 + 4), b0 = *(const GAS f32x4*)(gb + c0), b1 = *(const GAS f32x4*)(gb + c0 + 4);
        for (int r = 0; r < 64; ++r) { const size_t off = (size_t)(t0 + r) * 2048 + c0;
            const v4u ow = *(const GAS v4u*)(OY + off), sw = *(const GAS v4u*)(SG + off);
            f32x4 o0 = (f32x4){bfl(ow.x), bfh(ow.x), bfl(ow.y), bfh(ow.y)}, o1 = (f32x4){bfl(ow.z), bfh(ow.z), bfl(ow.w), bfh(ow.w)};
            const f32x4 s0 = (f32x4){bfl(sw.x), bfh(sw.x), bfl(sw.y), bfh(sw.y)}, s1 = (f32x4){bfl(sw.z), bfh(sw.z), bfl(sw.w), bfh(sw.w)};
            const float mean = wave_sum((o0.x + o0.y) + (o0.z + o0.w) + (o1.x + o1.y) + (o1.z + o1.w)) * (1.0f / 512.0f);
            o0 = o0 - mean; o1 = o1 - mean;
            const float var = wave_sum((o0.x * o0.x + o0.y * o0.y) + (o0.z * o0.z + o0.w * o0.w) + (o1.x * o1.x + o1.y * o1.y) + (o1.z * o1.z + o1.w * o1.w)) * (1.0f / 512.0f);
            const float rstd = 1.0f / sqrtf(var + 1e-6f);
            const f32x4 y0 = (o0 * rstd * g0 + b0) * s0, y1 = (o1 * rstd * g1 + b1) * s1;
            v4u w; w.x = pk2(y0.x, y0.y); w.y = pk2(y0.z, y0.w); w.z = pk2(y1.x, y1.y); w.w = pk2(y1.z, y1.w);
            *(GAS v4u*)(OY + off) = w; }
    }
}

__device__ __forceinline__ void conv_phase(LAS unsigned char* lds, const bf16* U, const float* wdw, const float* bdw, const float* lg, const float* lb, bf16* UC, int tid, int lane, int wave, int G) {
    constexpr int T = 32, ROWS = T + 30;
    asm volatile("" : "+v"(tid), "+v"(lane));
    LAS unsigned* tile = (LAS unsigned*)lds;
    LAS float* red = (LAS float*)(lds + ROWS * 2048);
    LAS float* stats = red + 8 * 32 * 2;
    const int c0 = 2 * tid;
    float w0[31], w1[31];
#pragma unroll
    for (int t = 0; t < 31; ++t) { w0[t] = wdw[t * 1024 + c0]; w1[t] = wdw[t * 1024 + c0 + 1]; }
    const float bd0 = bdw[c0], bd1 = bdw[c0 + 1], g0 = lg[c0], g1 = lg[c0 + 1], b0 = lb[c0], b1 = lb[c0 + 1];
    for (int tl = blockIdx.x; tl < 32768 / T; tl += G) {
        const int row_base = tl * T, s0 = row_base % 2048;
        for (int e = tid; e < ROWS * 128; e += 512) { const int r = e >> 7, p = e & 127; v4u val = (v4u){0u, 0u, 0u, 0u};
            if (s0 - 30 + r >= 0) val = *(const GAS v4u*)(U + (size_t)(row_base - 30 + r) * 1024 + p * 8);
            *(LAS v4u*)(lds + r * 2048 + p * 16) = val; }
        __syncthreads();
        float a0[T], a1[T];
#pragma unroll
        for (int j = 0; j < T; ++j) { a0[j] = bd0; a1[j] = bd1; }
#pragma unroll
        for (int r = 0; r < ROWS; ++r) { const unsigned xw = tile[r * 512 + tid]; const float x0 = bfl(xw), x1 = bfh(xw);
#pragma unroll
            for (int t = 0; t < 31; ++t) { const int j = r - t; if (j >= 0 && j < T) { a0[j] += w0[t] * x0; a1[j] += w1[t] * x1; } } }
#pragma unroll
        for (int j = 0; j < T; ++j) { const float s = wave_sum(a0[j] + a1[j]), q = wave_sum(a0[j] * a0[j] + a1[j] * a1[j]);
            if (lane == 0) { red[(wave * 32 + j) * 2] = s; red[(wave * 32 + j) * 2 + 1] = q; } }
        __syncthreads();
        if (tid < 32) { float S = 0.f, Q = 0.f;
#pragma unroll
            for (int w = 0; w < 8; ++w) { S += red[(w * 32 + tid) * 2]; Q += red[(w * 32 + tid) * 2 + 1]; }
            const float mean = S * (1.0f / 1024.0f); float var = Q * (1.0f / 1024.0f) - mean * mean; var = var < 0.f ? 0.f : var;
            stats[tid * 2] = mean; stats[tid * 2 + 1] = 1.0f / sqrtf(var + 1e-6f); }
        __syncthreads();
#pragma unroll
        for (int j = 0; j < T; ++j) { const float mean = stats[2 * j], rstd = stats[2 * j + 1];
            float y0 = (a0[j] - mean) * rstd * g0 + b0, y1 = (a1[j] - mean) * rstd * g1 + b1;
            y0 = y0 * sigm(y0); y1 = y1 * sigm(y1);
            *(GAS unsigned*)(UC + (size_t)(row_base + j) * 1024 + c0) = pk2(y0, y1); }
        __syncthreads();
    }
}

typedef short s16x4_r __attribute__((ext_vector_type(4)));
typedef short v4i16_r __attribute__((ext_vector_type(4)));
typedef unsigned u32x2_r __attribute__((ext_vector_type(2)));
typedef __bf16 bf16x2_r __attribute__((ext_vector_type(2)));
typedef float f32x2_r __attribute__((ext_vector_type(2)));
__device__ __forceinline__ unsigned cvt2r(float lo, float hi) { f32x2_r v = {lo, hi}; bf16x2_r b = __builtin_convertvector(v, bf16x2_r); return __builtin_bit_cast(unsigned, b); }
__device__ __forceinline__ s16x4_r tr4(const LAS unsigned char* p) { return __builtin_bit_cast(s16x4_r, __builtin_amdgcn_ds_read_tr16_b64_v4i16((LAS v4i16_r*)p)); }
#define MFMA16(a, b, c) __builtin_amdgcn_mfma_f32_16x16x32_bf16((a), (b), (c), 0, 0, 0)
constexpr int RQ_STR = 528, RK_STR = 544, RV_STR = 288, RS_STR = 144;
constexpr int RQ_OFF = 0, RK_OFF = RQ_OFF + 64 * RQ_STR, RV_OFF = RK_OFF + 64 * RK_STR, RS_OFF = RV_OFF + 64 * RV_STR, RET_LDS_END = RS_OFF + 64 * RS_STR;
static_assert(RET_LDS_END <= 131072, "retention LDS");
template <bool STORE = true> __device__ __forceinline__ void retention_phase(LAS unsigned char* lds, const bf16* Q, const bf16* Kb, bf16* V, float* stats, int tid, int lane, int wave, int G, int never = 0) {
    asm volatile("" : "+v"(tid), "+v"(lane));
    const int r = lane & 15, g = lane >> 4;
    for (int un = blockIdx.x; un < 256; un += G) {
        const int sl = un & 3, h = (un >> 2) & 3, b = un >> 4;
        const float gC = expf(128.0f * log1pf(-exp2f(-5.0f - (float)h)));
        const bf16* qg = Q + (size_t)b * 2048 * 1024 + h * 256;
        const bf16* kg = Kb + (size_t)b * 2048 * 1024 + h * 256;
        bf16* vg = V + (size_t)b * 2048 * 2048 + h * 512 + sl * 128;
        f32x4 Z[16];
#pragma unroll
        for (int i = 0; i < 16; ++i) Z[i] = (f32x4){0.f, 0.f, 0.f, 0.f};
        v4u sq[4], sk[4], sv[2];
#define R_LOAD(tt) do { _Pragma("unroll") for (int i = 0; i < 4; ++i) { const int e = tid + 512 * i, row = e >> 5, p = e & 31; \
            sq[i] = *(const GAS v4u*)(qg + (size_t)(64 * (tt) + row) * 1024 + p * 8); sk[i] = *(const GAS v4u*)(kg + (size_t)(64 * (tt) + row) * 1024 + p * 8); } \
        _Pragma("unroll") for (int i = 0; i < 2; ++i) { const int e = tid + 512 * i, row = e >> 4, p = e & 15; sv[i] = *(const GAS v4u*)(vg + (size_t)(64 * (tt) + row) * 2048 + p * 8); } } while (0)
        R_LOAD(0);
        for (int t = 0; t < 32; ++t) {
            __syncthreads();
#pragma unroll
            for (int i = 0; i < 4; ++i) { const int e = tid + 512 * i, row = e >> 5, p = e & 31;
                *(LAS v4u*)(lds + RQ_OFF + row * RQ_STR + p * 16) = sq[i]; *(LAS v4u*)(lds + RK_OFF + row * RK_STR + p * 16) = sk[i]; }
#pragma unroll
            for (int i = 0; i < 2; ++i) { const int e = tid + 512 * i, row = e >> 4, p = e & 15; *(LAS v4u*)(lds + RV_OFF + row * RV_STR + p * 16) = sv[i]; }
            __syncthreads();
            if (t + 1 < 32) R_LOAD(t + 1);
            { const int ib = wave & 3, jb0 = 2 * (wave >> 2);
              f32x4 s0 = (f32x4){0.f, 0.f, 0.f, 0.f}, s1 = s0;
              const LAS unsigned char* qp = lds + RQ_OFF + (16 * ib + r) * RQ_STR + 16 * g;
              const LAS unsigned char* kp = lds + RK_OFF + (16 * jb0 + r) * RK_STR + 16 * g;
#pragma unroll
              for (int kk = 0; kk < 8; ++kk) { const bf16x8 bq = *(const LAS bf16x8*)(qp + 64 * kk), a0 = *(const LAS bf16x8*)(kp + 64 * kk), a1 = *(const LAS bf16x8*)(kp + 16 * RK_STR + 64 * kk);
                  s0 = MFMA16(a0, bq, s0); s1 = MFMA16(a1, bq, s1); }
              const int iq = 16 * ib + r, j0 = 16 * jb0 + 4 * g;
#pragma unroll
              for (int e = 0; e < 4; ++e) { if (j0 + e > iq) s0[e] = 0.f; if (j0 + 16 + e > iq) s1[e] = 0.f; }
              u32x2_r w0, w1; w0.x = cvt2r(s0[0], s0[1]); w0.y = cvt2r(s0[2], s0[3]); w1.x = cvt2r(s1[0], s1[1]); w1.y = cvt2r(s1[2], s1[3]);
              *(LAS u32x2_r*)(lds + RS_OFF + iq * RS_STR + j0 * 2) = w0; *(LAS u32x2_r*)(lds + RS_OFF + iq * RS_STR + (j0 + 16) * 2) = w1; }
            bf16x8 vf[2];
#pragma unroll
            for (int kk = 0; kk < 2; ++kk) { const LAS unsigned char* vp = lds + RV_OFF + (32 * kk + 4 * g + (r >> 2)) * RV_STR + (16 * wave + 4 * (r & 3)) * 2;
                const s16x4_r lo = tr4(vp), hi = tr4(vp + 16 * RV_STR); vf[kk] = __builtin_shufflevector(lo, hi, 0, 1, 2, 3, 4, 5, 6, 7); }
            if (t > 0 && (t & 1) == 0) {
#pragma unroll
                for (int i = 0; i < 16; ++i) Z[i] = Z[i] * gC; }
            __syncthreads();
            f32x4 oacc[4];
#pragma unroll
            for (int nt = 0; nt < 4; ++nt) oacc[nt] = (f32x4){0.f, 0.f, 0.f, 0.f};
#pragma unroll
            for (int kk = 0; kk < 2; ++kk)
#pragma unroll
                for (int nt = 0; nt < 4; ++nt) { const LAS unsigned char* sp = lds + RS_OFF + (16 * nt + r) * RS_STR + (32 * kk + 4 * g) * 2;
                    const s16x4_r lo = *(const LAS s16x4_r*)sp, hi = *(const LAS s16x4_r*)(sp + 32);
                    oacc[nt] = MFMA16(vf[kk], __builtin_shufflevector(lo, hi, 0, 1, 2, 3, 4, 5, 6, 7), oacc[nt]); }
#pragma unroll
            for (int kk = 0; kk < 8; ++kk) { v4u zw; zw.x = cvt2r(Z[2 * kk][0], Z[2 * kk][1]); zw.y = cvt2r(Z[2 * kk][2], Z[2 * kk][3]); zw.z = cvt2r(Z[2 * kk + 1][0], Z[2 * kk + 1][1]); zw.w = cvt2r(Z[2 * kk + 1][2], Z[2 * kk + 1][3]);
                const bf16x8 za = __builtin_bit_cast(bf16x8, zw);
#pragma unroll
                for (int nt = 0; nt < 4; ++nt) { const LAS unsigned char* qp = lds + RQ_OFF + (16 * nt + r) * RQ_STR + (32 * kk + 4 * g) * 2;
                    const s16x4_r lo = *(const LAS s16x4_r*)qp, hi = *(const LAS s16x4_r*)(qp + 32);
                    oacc[nt] = MFMA16(za, __builtin_shufflevector(lo, hi, 0, 1, 2, 3, 4, 5, 6, 7), oacc[nt]); }
                __builtin_amdgcn_sched_barrier(0); }
#pragma unroll
            for (int mt = 0; mt < 16; ++mt)
#pragma unroll
                for (int kk = 0; kk < 2; ++kk) { const LAS unsigned char* kp = lds + RK_OFF + (32 * kk + 4 * g + (r >> 2)) * RK_STR + (16 * mt + 4 * (r & 3)) * 2;
                    const s16x4_r lo = tr4(kp), hi = tr4(kp + 16 * RK_STR);
                    Z[mt] = MFMA16(__builtin_shufflevector(lo, hi, 0, 1, 2, 3, 4, 5, 6, 7), vf[kk], Z[mt]);
                    if (kk == 1 && (mt & 1) == 1) __builtin_amdgcn_sched_barrier(0); }
#pragma unroll
            for (int nt = 0; nt < 4; ++nt) { float s = (oacc[nt][0] + oacc[nt][1]) + (oacc[nt][2] + oacc[nt][3]), q = (oacc[nt][0] * oacc[nt][0] + oacc[nt][1] * oacc[nt][1]) + (oacc[nt][2] * oacc[nt][2] + oacc[nt][3] * oacc[nt][3]);
                s += __shfl_xor(s, 16); s += __shfl_xor(s, 32); q += __shfl_xor(q, 16); q += __shfl_xor(q, 32);
                if (g < 2) atomicAdd(stats + ((size_t)h * 32768 + (size_t)(b * 2048 + 64 * t + 16 * nt + r)) * 2 + g, g ? q : s); }
#pragma unroll
            for (int nt = 0; nt < 4; ++nt) { u32x2_r w; w.x = cvt2r(oacc[nt][0], oacc[nt][1]); w.y = cvt2r(oacc[nt][2], oacc[nt][3]);
                if (STORE || (never && w.x == 0x12345678u)) *(GAS u32x2_r*)(vg + (size_t)(64 * t + 16 * nt + r) * 2048 + 16 * wave + 4 * g) = w; }
        }
#undef R_LOAD
    }
}

#if MK_NAIVE_RET
__device__ __forceinline__ void retention_phase_naive(LAS unsigned char* lds, const bf16* Q, const bf16* Kb, bf16* V, int tid, int lane, int wave, int G) {
    LAS bf16* qs = (LAS bf16*)lds;
    LAS bf16* ks = (LAS bf16*)(lds + 32768);
    LAS bf16* vs = (LAS bf16*)(lds + 65536);
    LAS float* po = (LAS float*)(lds + 81920);
    const int d = tid & 127, qq = tid >> 7;
    for (int un = blockIdx.x; un < 256; un += G) {
        const int sl = un & 3, h = (un >> 2) & 3, b = un >> 4;
        const float gC = expf(128.0f * log1pf(-exp2f(-5.0f - (float)h)));
        float st[64];
#pragma unroll
        for (int i = 0; i < 64; ++i) st[i] = 0.f;
        for (int hc = 0; hc < 2048 / 64; ++hc) {
            const size_t row0 = (size_t)b * 2048 + hc * 64;
            if (hc > 0 && (hc & 1) == 0) {
#pragma unroll
                for (int i = 0; i < 64; ++i) st[i] *= gC; }
            __syncthreads();
            for (int e = tid; e < 2048; e += 512) { const int r = e >> 5, p = e & 31;
                *(LAS v4u*)(qs + r * 256 + p * 8) = *(const GAS v4u*)(Q + (row0 + r) * 1024 + h * 256 + p * 8);
                *(LAS v4u*)(ks + r * 256 + p * 8) = *(const GAS v4u*)(Kb + (row0 + r) * 1024 + h * 256 + p * 8); }
            for (int e = tid; e < 1024; e += 512) { const int r = e >> 4, p = e & 15;
                *(LAS v4u*)(vs + r * 128 + p * 8) = *(const GAS v4u*)(V + (row0 + r) * 2048 + h * 512 + sl * 128 + p * 8); }
            __syncthreads();
            for (int tb = 0; tb < 4; ++tb) {
                for (int tt = 0; tt < 16; ++tt) { const int n = tb * 16 + tt;
                    const float vv = __uint_as_float(((unsigned)vs[n * 128 + d]) << 16);
                    float acc = 0.f;
#pragma unroll
                    for (int i8 = 0; i8 < 8; ++i8) { const v4u kw = *(const LAS v4u*)(ks + n * 256 + qq * 64 + i8 * 8), qw = *(const LAS v4u*)(qs + n * 256 + qq * 64 + i8 * 8);
                        const float kf[8] = {bfl(kw.x), bfh(kw.x), bfl(kw.y), bfh(kw.y), bfl(kw.z), bfh(kw.z), bfl(kw.w), bfh(kw.w)};
                        const float qf[8] = {bfl(qw.x), bfh(qw.x), bfl(qw.y), bfh(qw.y), bfl(qw.z), bfh(qw.z), bfl(qw.w), bfh(qw.w)};
#pragma unroll
                        for (int e = 0; e < 8; ++e) { st[i8 * 8 + e] += kf[e] * vv; acc += qf[e] * st[i8 * 8 + e]; } }
                    po[(tt * 4 + qq) * 128 + d] = acc; }
                __syncthreads();
                for (int e = tid; e < 2048; e += 512) { const int tt = e >> 7, dd = e & 127;
                    const float s = (po[(tt * 4 + 0) * 128 + dd] + po[(tt * 4 + 1) * 128 + dd]) + (po[(tt * 4 + 2) * 128 + dd] + po[(tt * 4 + 3) * 128 + dd]);
                    V[(row0 + tb * 16 + tt) * 2048 + h * 512 + sl * 128 + dd] = (bf16)f2bf(s); }
                __syncthreads();
            }
        }
    }
}
#endif
#include <cstddef>

#ifndef PG8_SP2
#define PG8_SP2 true
#endif
#ifndef PG8_ALIGN
#define PG8_ALIGN true
#endif
#ifndef MK_SEAM78
#define MK_SEAM78 0
#endif
#ifndef MK_OPAQUE_TID
#define MK_OPAQUE_TID 1
#endif
#ifndef MK_NAIVE_RET
#define MK_NAIVE_RET 0
#endif
#ifndef MK_CHECK
#define MK_CHECK 0
#endif
#ifndef MK_N_LAUNCHES
#define MK_N_LAUNCHES 1
#endif
constexpr int NWAVES = 8;
constexpr int BATCH = 16, SEQ = 2048, D = 1024, M = BATCH * SEQ, DFF = 2816, NGU = 2 * DFF, NIN = 10240, RV = 2048, NMOD = 9 * D, CHUNK = 128, CONVW = 31;
constexpr float EPS = 1e-6f;
constexpr int NPHASE = 13;
constexpr int N_LAUNCHES = MK_N_LAUNCHES;
constexpr size_t MiB = 1u << 20;
constexpr size_t WS_CTL = 0, CTL_ZERO_BYTES = 2 * MiB;
constexpr size_t WS_MOD = 1 * MiB;
constexpr size_t WS_RSS2 = 1664 * 1024, WS_RSS3 = 1792 * 1024;
constexpr size_t WS_W = 2 * MiB;
constexpr size_t WE_GU1 = 0, WE_D1 = WE_GU1 + (size_t)D * NGU, WE_IN = WE_D1 + (size_t)DFF * D, WE_RO = WE_IN + (size_t)D * NIN, WE_CO = WE_RO + (size_t)RV * D,
                 WE_OUT = WE_CO + (size_t)D * D, WE_GU2 = WE_OUT + (size_t)D * D, WE_D2 = WE_GU2 + (size_t)D * NGU, WE_END = WE_D2 + (size_t)DFF * D;
static_assert(WS_W + WE_END * 2 <= 63 * MiB, "weights fit [2, 63) MiB");
constexpr size_t WS_XN = 64 * MiB;
constexpr size_t WS_ACT = 128 * MiB;
constexpr size_t WS_Q = 128 * MiB, WS_K = 192 * MiB, WS_V = 256 * MiB, WS_U = 384 * MiB, WS_UC = 448 * MiB;
constexpr size_t WS_G2 = 128 * MiB, WS_T = 384 * MiB, WS_H2 = 448 * MiB, WS_END = 512 * MiB;
static_assert(WS_ACT + (size_t)M * DFF * 2 <= WS_H2, "act and h2 do not overlap");
constexpr size_t DO_H1 = 0, DO_BIAS_IN = 64 * MiB, DO_BIAS_GU = DO_BIAS_IN + (size_t)16 * NIN * 4, DO_STATS = 66 * MiB;
constexpr int CW_BAR = 4096;

constexpr int RING_OFF = 0, RING_BYTES = 131072;
constexpr int LDSCTL_OFF = RING_BYTES, MISC_OFF = LDSCTL_OFF + 320;
constexpr int EC_OFF = 132096, EC_BYTES = 1024 + 6144 * 4;
constexpr int LDS_BYTES = 163840;
static_assert(MISC_OFF + 128 <= EC_OFF && EC_OFF + EC_BYTES <= LDS_BYTES && EC_OFF == (int)pg8::PG8_EC_OFF && MISC_OFF + 64 == (int)pg8::PG8_ECPM_OFF, "LDS map");

struct Args { const float* in[24]; float* out; unsigned char* ws; int ph_lo, ph_hi, li, pad; };

__device__ __forceinline__ int src_col(int mode, int nn) {
    if (mode == 1) { const int blk = nn >> 8, w = nn & 255; return (w < 128) ? (blk * 128 + w) : (DFF + blk * 128 + (w - 128)); }
    if (mode == 2) { if (nn < 4096) return nn; if (nn < 6144) { const int t = nn - 4096, blk = t >> 8, w = t & 255; return (w < 128) ? (6144 + blk * 128 + w) : (7168 + blk * 128 + (w - 128)); } if (nn < 8192) return nn - 2048; return nn; }
    return nn;
}
__device__ __forceinline__ void p0_transpose_item(const float* W, int K, int N, bf16* WT, int mode, LAS float* scr, int item, int lane) {
    const int nblk = N / 32, kb = item / nblk, nb = item % nblk, k0 = 64 * kb, n0 = 32 * nb;
    const int sc = src_col(mode, n0 + (lane & 31));
#pragma unroll 8
    for (int i = 0; i < 32; ++i) { const int kk = 2 * i + (lane >> 5); scr[kk * 33 + (lane & 31)] = W[(size_t)(k0 + kk) * N + sc]; }
    LDS_WAIT(); asm volatile("" ::: "memory");
    const int c = lane & 7;
#pragma unroll
    for (int j = 0; j < 4; ++j) { const int n = (lane >> 3) + 8 * j; const LAS float* s = scr + (8 * c) * 33 + n;
        v4u o; o.x = pk2(s[0 * 33], s[1 * 33]); o.y = pk2(s[2 * 33], s[3 * 33]); o.z = pk2(s[4 * 33], s[5 * 33]); o.w = pk2(s[6 * 33], s[7 * 33]);
        *(GAS v4u*)(WT + (size_t)(n0 + n) * K + k0 + 8 * c) = o; }
    LDS_WAIT(); asm volatile("" ::: "memory");
}

__device__ __forceinline__ void modnorm_rows(const float* h, const float* g, const float* sh, const float* sc, bf16* xn, int row_first, int lane) {
    f32x4 gs[4], sv[4];
#pragma unroll
    for (int j = 0; j < 4; ++j) { const int c = 4 * lane + 256 * j; const f32x4 gg = *(const GAS f32x4*)(g + c), ss = *(const GAS f32x4*)(sc + c); gs[j] = gg * (ss + 1.0f); sv[j] = *(const GAS f32x4*)(sh + c); }
    for (int r = 0; r < 16; ++r) { const size_t row = (size_t)(row_first + r);
        const GAS f32x4* xr = (const GAS f32x4*)(h + row * D) + lane; f32x4 v[4]; float s = 0.f;
#pragma unroll
        for (int j = 0; j < 4; ++j) { v[j] = xr[64 * j]; s += (v[j].x * v[j].x + v[j].y * v[j].y) + (v[j].z * v[j].z + v[j].w * v[j].w); }
        const float rstd = 1.0f / sqrtf(wave_sum(s) * (1.0f / D) + EPS);
        GAS unsigned long long* o8 = (GAS unsigned long long*)(xn + row * D) + lane;
#pragma unroll
        for (int j = 0; j < 4; ++j) { const f32x4 y = v[j] * rstd * gs[j] + sv[j]; o8[64 * j] = (unsigned long long)pk2(y.x, y.y) | ((unsigned long long)pk2(y.z, y.w) << 32); } }
}

__device__ __forceinline__ void bias_columns(LAS unsigned char* lds, const float* modp, const bf16* Wt_in, const bf16* Wt_gu2, float* bias_in, float* bias_gu, int tid, int lane, int wave, int G) {
    LAS float* shl = (LAS float*)lds;
    for (int wg = blockIdx.x; wg < 248; wg += G) {
        const bool second = wg >= 160; const bf16* Wt = second ? Wt_gu2 : Wt_in; const int n0 = second ? (wg - 160) * 64 : wg * 64;
        __syncthreads();
        for (int e = tid; e < 16 * 1024; e += 512) { const int b = e >> 10, k = e & 1023; shl[e] = modp[(size_t)b * NMOD + (second ? 6 : 3) * D + k]; }
        __syncthreads();
#pragma unroll 1
        for (int half = 0; half < 2; ++half) {
            float wf[4][16];
#pragma unroll
            for (int rr = 0; rr < 4; ++rr)
#pragma unroll
                for (int j = 0; j < 2; ++j) { const v4u w = *(const GAS v4u*)(Wt + (size_t)(n0 + wave * 8 + half * 4 + rr) * D + 8 * lane + 512 * j);
                    wf[rr][8 * j + 0] = bfl(w.x); wf[rr][8 * j + 1] = bfh(w.x); wf[rr][8 * j + 2] = bfl(w.y); wf[rr][8 * j + 3] = bfh(w.y); wf[rr][8 * j + 4] = bfl(w.z); wf[rr][8 * j + 5] = bfh(w.z); wf[rr][8 * j + 6] = bfl(w.w); wf[rr][8 * j + 7] = bfh(w.w); }
            float mine[4] = {0.f, 0.f, 0.f, 0.f};
#pragma unroll 1
            for (int b = 0; b < 16; ++b) { float sh[16];
#pragma unroll
                for (int j = 0; j < 2; ++j) { const f32x4 s0 = *(const LAS f32x4*)(shl + b * 1024 + 8 * lane + 512 * j), s1 = *(const LAS f32x4*)(shl + b * 1024 + 8 * lane + 512 * j + 4);
                    sh[8 * j] = s0.x; sh[8 * j + 1] = s0.y; sh[8 * j + 2] = s0.z; sh[8 * j + 3] = s0.w; sh[8 * j + 4] = s1.x; sh[8 * j + 5] = s1.y; sh[8 * j + 6] = s1.z; sh[8 * j + 7] = s1.w; }
#pragma unroll
                for (int rr = 0; rr < 4; ++rr) { float s = 0.f;
#pragma unroll
                    for (int e = 0; e < 16; ++e) s += sh[e] * wf[rr][e];
                    s = wave_sum(s); mine[rr] = (lane == b) ? s : mine[rr]; } }
#pragma unroll
            for (int rr = 0; rr < 4; ++rr) { const int n = n0 + wave * 8 + half * 4 + rr;
                if (lane < 16) { if (second) bias_gu[(size_t)lane * NGU + n] = mine[rr]; else bias_in[(size_t)lane * NIN + n] = mine[rr]; } }
        }
    }
}

template <int OFF> __device__ __forceinline__ const void* karg_ptr() {
#if defined(__HIP_DEVICE_COMPILE__)
    const void* p; auto ka = __builtin_amdgcn_kernarg_segment_ptr();
    asm volatile("s_load_dwordx2 %0, %1, %2\n\ts_waitcnt lgkmcnt(0)" : "=s"(p) : "s"(ka), "i"(OFF) : "memory"); return p;
#else
    return nullptr;
#endif
}
#ifndef MK_LAZYARGS
#define MK_LAZYARGS 1
#endif
#if MK_LAZYARGS
#define AIN(i) ((const float*)karg_ptr<8 * (i)>())
#define AOUT ((float*)karg_ptr<192>())
#define AWS ((unsigned char*)karg_ptr<200>())
#else
#define AIN(i) (args.in[i])
#define AOUT (args.out)
#define AWS (args.ws)
#endif
static_assert(offsetof(Args, out) == 192 && offsetof(Args, ws) == 200 && offsetof(Args, ph_lo) == 208, "Args layout");
__global__ void __launch_bounds__(NWAVES * 64, 2) mk_fwd(Args args) {
    extern __shared__ __attribute__((aligned(16))) unsigned char lds_raw[];
    LAS unsigned char* lds = (LAS unsigned char*)lds_raw;
    volatile LAS unsigned* MISC = (volatile LAS unsigned*)(lds + MISC_OFF);
    const int tid = threadIdx.x, lane = tid & 63, wave = __builtin_amdgcn_readfirstlane(tid >> 6);
    const int G = gridDim.x;
#define KWS (AWS)
#define KCTL ((gu32*)(AWS + WS_CTL))
#define KMOD ((float*)(AWS + WS_MOD))
#define KRSS2 ((float*)(AWS + WS_RSS2))
#define KRSS3 ((float*)(AWS + WS_RSS3))
#define KWB ((bf16*)(AWS + WS_W))
#define KXN ((bf16*)(AWS + WS_XN))
#define KDOB ((unsigned char*)AOUT)
#define KH1 ((bf16*)((unsigned char*)AOUT + DO_H1))
#define KH2 ((bf16*)(AWS + WS_H2))
#define KBIN ((float*)((unsigned char*)AOUT + DO_BIAS_IN))
#define KBGU ((float*)((unsigned char*)AOUT + DO_BIAS_GU))
#define KSTATS ((float*)((unsigned char*)AOUT + DO_STATS))
#define KX (AIN(0))
    for (int u = tid; u < (LDS_BYTES - LDSCTL_OFF) / 4; u += NWAVES * 64) ((LAS unsigned*)(lds + LDSCTL_OFF))[u] = 0u;
    __syncthreads();
    XcdBarrier bar; bar.bar = (unsigned*)(KCTL + CW_BAR); bar.x = 0; bar.st = nullptr;
    if (N_LAUNCHES == 1) bar = xcd_barrier_post((unsigned*)(KCTL + CW_BAR), MISC + 8);
    const int lo = args.ph_lo, hi = args.ph_hi;
#define IN(k) (lo <= (k) && (k) < hi)
#define SEAM(k) do { if (IN(k) && IN((k) + 1)) xcd_barrier(bar); } while (0)
    const int gw = blockIdx.x * NWAVES + wave, NGW = G * NWAVES;

    if (IN(0)) {
        LAS float* scr = (LAS float*)(lds + RING_OFF + wave * 16384);
        constexpr int I_GU = (D / 64) * (NGU / 32), I_D = (DFF / 64) * (D / 32), I_IN = (D / 64) * (NIN / 32), I_RO = (RV / 64) * (D / 32), I_SQ = (D / 64) * (D / 32);
        constexpr int NITEMS = 2 * I_GU + 2 * I_D + I_IN + I_RO + 2 * I_SQ;
        for (int it = gw; it < NITEMS; it += NGW) {
            int r = it;
            if (r < I_GU) { p0_transpose_item(AIN(6), D, NGU, KWB + WE_GU1, 1, scr, r, lane); continue; } r -= I_GU;
            if (r < I_D)  { p0_transpose_item(AIN(7), DFF, D, KWB + WE_D1, 0, scr, r, lane); continue; } r -= I_D;
            if (r < I_IN) { p0_transpose_item(AIN(9), D, NIN, KWB + WE_IN, 2, scr, r, lane); continue; } r -= I_IN;
            if (r < I_RO) { p0_transpose_item(AIN(12), RV, D, KWB + WE_RO, 0, scr, r, lane); continue; } r -= I_RO;
            if (r < I_SQ) { p0_transpose_item(AIN(17), D, D, KWB + WE_CO, 0, scr, r, lane); continue; } r -= I_SQ;
            if (r < I_SQ) { p0_transpose_item(AIN(19), D, D, KWB + WE_OUT, 0, scr, r, lane); continue; } r -= I_SQ;
            if (r < I_GU) { p0_transpose_item(AIN(21), D, NGU, KWB + WE_GU2, 1, scr, r, lane); continue; } r -= I_GU;
            p0_transpose_item(AIN(22), DFF, D, KWB + WE_D2, 0, scr, r, lane);
        }
        __syncthreads();
        LAS float* sc_l = (LAS float*)(lds + RING_OFF);
        const float* cin = AIN(1); const float* wmod = AIN(3); const float* bmod = AIN(4);
        for (int it = blockIdx.x; it < 18 * 16; it += G) {
            const int cb = it % 18, ks = it / 18, n = cb * 512 + tid, k0 = ks * 64;
            for (int e = tid; e < 16 * 64; e += NWAVES * 64) { const float cv = cin[(e >> 6) * D + k0 + (e & 63)]; sc_l[e] = cv / (1.0f + expf(-cv)); }
            __syncthreads();
            float a[16];
#pragma unroll
            for (int b = 0; b < 16; ++b) a[b] = (ks == 0) ? bmod[n] : 0.f;
            for (int k = 0; k < 64; ++k) { const float w = wmod[(size_t)(k0 + k) * NMOD + n];
#pragma unroll
                for (int b = 0; b < 16; ++b) a[b] += sc_l[b * 64 + k] * w; }
#pragma unroll
            for (int b = 0; b < 16; ++b) atomicAdd(KMOD + (size_t)b * NMOD + n, a[b]);
            __syncthreads();
        }
    }
    SEAM(0);
    if (IN(1)) {
        for (int r0 = gw * 16; r0 < M; r0 += NGW * 16) { const int b = r0 / SEQ; modnorm_rows(KX, AIN(5), KMOD + (size_t)b * NMOD + 0 * D, KMOD + (size_t)b * NMOD + 1 * D, KXN, r0, lane); }
        for (size_t e = (size_t)blockIdx.x * 512 + tid; e < (size_t)M * 8 / 4; e += (size_t)G * 512) ((GAS f32x4*)KSTATS)[e] = (f32x4){0.f, 0.f, 0.f, 0.f};
        bias_columns(lds + RING_OFF, KMOD, KWB + WE_IN, KWB + WE_GU2, KBIN, KBGU, tid, lane, wave, G);
    }
    SEAM(1);
    if (IN(2)) { pg8::Gemm g{KXN, KWB + WE_GU1, M, NGU, D}; pg8::StaticOrder S; S.init(M, NGU, G, (int)blockIdx.x);
        pg8::EpiSwiGLU<false> E{(bf16*)(KWS + WS_ACT), DFF, pg8::EpiCache{}};
        pg8::gemm_phase<pg8::EpiSwiGLU<false>, pg8::StaticOrder, PG8_ALIGN, PG8_SP2>(lds + RING_OFF, g, S, E); }
    SEAM(2);
    if (IN(3)) { pg8::Gemm g{(const bf16*)(KWS + WS_ACT), KWB + WE_D1, M, D, DFF}; pg8::StaticOrder S; S.init(M, D, G, (int)blockIdx.x);
        pg8::EpiResNorm<false> E{KX, KH1, KXN, KRSS2, KMOD + 2 * D, AIN(8), KMOD + 4 * D, NMOD, 0.5f};
        pg8::gemm_phase<pg8::EpiResNorm<false>, pg8::StaticOrder, PG8_ALIGN, PG8_SP2>(lds + RING_OFF, g, S, E); }
    SEAM(3);
    if (IN(4)) { if (tid == 0) MISC[16] = 0xffffffffu; pg8::Gemm g{KXN, KWB + WE_IN, M, 6144, D}; pg8::StaticOrder S; S.init(M, 6144, G, (int)blockIdx.x);
        pg8::EpiQKVU E{(bf16*)(KWS + WS_Q), (bf16*)(KWS + WS_K), (bf16*)(KWS + WS_V), (bf16*)(KWS + WS_U), (const int*)AIN(2), pg8::EpiCache{KRSS2, KBIN, NIN, 6144}};
        pg8::gemm_phase<pg8::EpiQKVU, pg8::StaticOrder, PG8_ALIGN, PG8_SP2>(lds + RING_OFF, g, S, E); }
    SEAM(4);
    if (IN(5)) { conv_phase(lds + RING_OFF, (const bf16*)(KWS + WS_U), AIN(13), AIN(14), AIN(15), AIN(16), (bf16*)(KWS + WS_UC), tid, lane, wave, G);
        retention_phase(lds + RING_OFF, (const bf16*)(KWS + WS_Q), (const bf16*)(KWS + WS_K), (bf16*)(KWS + WS_V), KSTATS, tid, lane, wave, G); }
    SEAM(5);
    if (IN(6)) { if (tid == 0) MISC[16] = 0xffffffffu; pg8::Gemm g{KXN, KWB + WE_IN + (size_t)6144 * D, M, 4096, D}; pg8::StaticOrder S; S.init(M, 4096, G, (int)blockIdx.x);
        pg8::EpiYG E{(bf16*)(KWS + WS_V), (bf16*)(KWS + WS_G2), KSTATS, AIN(10), AIN(11), pg8::EpiCache{KRSS2, KBIN + 6144, NIN, 4096}};
        pg8::gemm_phase<pg8::EpiYG, pg8::StaticOrder, PG8_ALIGN, PG8_SP2>(lds + RING_OFF, g, S, E); }
    SEAM(6);
    if (IN(7)) { pg8::Gemm g{(const bf16*)(KWS + WS_UC), KWB + WE_CO, M, D, D}; pg8::StaticOrder S; S.init(M, D, G, (int)blockIdx.x);
        pg8::EpiConvO E{(bf16*)(KWS + WS_T), (const bf16*)(KWS + WS_G2), AIN(18)};
        pg8::gemm_phase<pg8::EpiConvO, pg8::StaticOrder, PG8_ALIGN, PG8_SP2>(lds + RING_OFF, g, S, E); }
#if MK_SEAM78
    SEAM(7);
#endif
    if (IN(8)) { pg8::Gemm g{(const bf16*)(KWS + WS_V), KWB + WE_RO, M, D, RV}; pg8::StaticOrder S; S.init(M, D, G, (int)blockIdx.x);
        pg8::EpiRetO E{(bf16*)(KWS + WS_T), (const bf16*)(KWS + WS_G2)};
        pg8::gemm_phase<pg8::EpiRetO, pg8::StaticOrder, PG8_ALIGN, PG8_SP2>(lds + RING_OFF, g, S, E); }
    SEAM(8);
    if (IN(9)) { pg8::Gemm g{(const bf16*)(KWS + WS_T), KWB + WE_OUT, M, D, D}; pg8::StaticOrder S; S.init(M, D, G, (int)blockIdx.x);
        pg8::EpiResNorm<true> E{KH1, KH2, KXN, KRSS3, KMOD + 5 * D, AIN(20), KMOD + 7 * D, NMOD, 1.0f};
        pg8::gemm_phase<pg8::EpiResNorm<true>, pg8::StaticOrder, PG8_ALIGN, PG8_SP2>(lds + RING_OFF, g, S, E); }
    SEAM(9);
    if (IN(10)) { if (tid == 0) MISC[16] = 0xffffffffu; pg8::Gemm g{KXN, KWB + WE_GU2, M, NGU, D}; pg8::StaticOrder S; S.init(M, NGU, G, (int)blockIdx.x);
        pg8::EpiSwiGLU<true> E{(bf16*)(KWS + WS_ACT), DFF, pg8::EpiCache{KRSS3, KBGU, NGU, NGU}};
        pg8::gemm_phase<pg8::EpiSwiGLU<true>, pg8::StaticOrder, PG8_ALIGN, PG8_SP2>(lds + RING_OFF, g, S, E); }
    SEAM(10);
    if (IN(11)) { pg8::Gemm g{(const bf16*)(KWS + WS_ACT), KWB + WE_D2, M, D, DFF}; pg8::StaticOrder S; S.init(M, D, G, (int)blockIdx.x);
        pg8::EpiResidOut E{KH2, AOUT, KMOD + 8 * D, NMOD, 0.5f};
        pg8::gemm_phase<pg8::EpiResidOut, pg8::StaticOrder, PG8_ALIGN, PG8_SP2>(lds + RING_OFF, g, S, E); }
    SEAM(11);
    if (IN(12)) { float* hbuf = AOUT; for (int r0 = gw * 16; r0 < M; r0 += NGW * 16) {
        const float* gf = AIN(23); f32x4 gs[4];
#pragma unroll
        for (int j = 0; j < 4; ++j) gs[j] = *(const GAS f32x4*)(gf + 4 * lane + 256 * j);
        for (int r = 0; r < 16; ++r) { GAS f32x4* xr = (GAS f32x4*)(hbuf + (size_t)(r0 + r) * D) + lane; f32x4 v[4]; float s = 0.f;
#pragma unroll
            for (int j = 0; j < 4; ++j) { v[j] = xr[64 * j]; s += (v[j].x * v[j].x + v[j].y * v[j].y) + (v[j].z * v[j].z + v[j].w * v[j].w); }
            const float rstd = 1.0f / sqrtf(wave_sum(s) * (1.0f / D) + EPS);
#pragma unroll
            for (int j = 0; j < 4; ++j) xr[64 * j] = v[j] * rstd * gs[j]; } } }
#undef IN
#undef SEAM
#undef KWS
#undef KCTL
#undef KMOD
#undef KRSS2
#undef KRSS3
#undef KWB
#undef KXN
#undef KDOB
#undef KH1
#undef KH2
#undef KBIN
#undef KBGU
#undef KSTATS
#undef KX
}


#if MK_CHECK
constexpr int NSAMP = 64;
constexpr size_t WS_CHK = 63 * MiB;
__device__ __forceinline__ int srow(int i) { switch (i) { case 0: return 0; case 1: return 1; case 2: return 29; case 3: return 30; case 4: return 31; case 5: return 127; case 6: return 128; case 7: return 255; case 8: return 2047; case 9: return 2048; case 10: return 2049; case 11: return 2078; case 12: return 4095; case 13: return 16384; case 14: return 32640; case 15: return 32767; default: return (i * 509 + 12345) & 32767; } }
__device__ __forceinline__ float b2f(bf16 v) { return __uint_as_float(((unsigned)v) << 16); }
__device__ __forceinline__ void upd(unsigned* res, int s, float err) { if (!(err == err)) err = 1e30f; atomicMax(res + s, __float_as_uint(err)); }
__device__ __forceinline__ float nerr(float got, float exp, float ta, float tr) { return fabsf(got - exp) / (ta + tr * fabsf(exp)); }
__device__ __forceinline__ float block_sum(float v, float* red) {
    v = wave_sum(v); __syncthreads(); if ((threadIdx.x & 63) == 0) red[threadIdx.x >> 6] = v; __syncthreads(); const float r = (red[0] + red[1]) + (red[2] + red[3]); __syncthreads(); return r; }
__device__ __forceinline__ float dsilu(float x) { return x / (1.0f + expf(-x)); }
__device__ __forceinline__ float dsig(float x) { return 1.0f / (1.0f + expf(-x)); }

__device__ __forceinline__ void true_xn(const bf16* Hrow, const float* g, const float* sh, const float* sc, float* arow, float* red, int tid) {
    float s = 0.f; for (int k = tid; k < D; k += 256) { const float v = b2f(Hrow[k]); arow[k] = v; s += v * v; }
    const float rstd = 1.0f / sqrtf(block_sum(s, red) / D + EPS);
    for (int k = tid; k < D; k += 256) arow[k] = arow[k] * rstd * g[k] * (1.0f + sc[k]) + sh[k];
    __syncthreads();
}
__global__ void __launch_bounds__(256) k_check(Args args, int stage, int mode) {
    __shared__ float arow[2816]; __shared__ float red[4]; __shared__ float sc_s[2048];
    const int i = blockIdx.x, r = srow(i), b = r / SEQ, tid = threadIdx.x;
    unsigned char* ws = args.ws; unsigned* res = (unsigned*)(ws + WS_CTL) + 8192;
    const float* modp = (const float*)(ws + WS_MOD) + (size_t)b * NMOD; const bf16* XN = (const bf16*)(ws + WS_XN);
    unsigned char* dob = (unsigned char*)args.out; const bf16* H1 = (const bf16*)(dob + DO_H1); const bf16* H2 = (const bf16*)(ws + WS_H2);
    float* EXP = (float*)(ws + WS_CHK) + (size_t)i * 2048;
    if (stage == 0) {
        const int bb = i & 15; const float* cin = args.in[1];
        for (int k = tid; k < D; k += 256) arow[k] = dsilu(cin[bb * D + k]);
        __syncthreads();
        const int n = tid * 36 + (i >> 4) * 9; float a = args.in[4][n];
        for (int k = 0; k < D; ++k) a += arow[k] * args.in[3][(size_t)k * NMOD + n];
        upd(res, 0, nerr(((const float*)(ws + WS_MOD))[(size_t)bb * NMOD + n], a, 2e-3f, 2e-3f));
        return;
    }
    if (stage == 1) {
        const float* src = args.in[0]; const float* g = args.in[5]; float s = 0.f;
        for (int k = tid; k < D; k += 256) { const float v = src[(size_t)r * D + k]; arow[k] = v; s += v * v; }
        const float rstd = 1.0f / sqrtf(block_sum(s, red) / D + EPS);
        for (int k = tid; k < D; k += 256) { const float e = arow[k] * rstd * g[k] * (1.0f + modp[1 * D + k]) + modp[0 * D + k]; upd(res, 1, nerr(b2f(XN[(size_t)r * D + k]), e, 0.02f, 0.01f)); }
        const float* bias_in = (const float*)(dob + DO_BIAS_IN); const float* bias_gu = (const float*)(dob + DO_BIAS_GU); const int bb = i & 15;
        const float* mb = (const float*)(ws + WS_MOD) + (size_t)bb * NMOD;
        { const int n = tid * 40 + (i >> 4) * 7; float a = 0.f; const int col = src_col(2, n); for (int k = 0; k < D; ++k) a += mb[3 * D + k] * args.in[9][(size_t)k * NIN + col]; upd(res, 1, nerr(bias_in[(size_t)bb * NIN + n], a, 2e-3f, 2e-3f)); }
        { const int n = tid * 22 + (i >> 4) * 5; float a = 0.f; const int col = src_col(1, n); for (int k = 0; k < D; ++k) a += mb[6 * D + k] * args.in[21][(size_t)k * NGU + col]; upd(res, 1, nerr(bias_gu[(size_t)bb * NGU + n], a, 2e-3f, 2e-3f)); }
        return;
    }
    if (stage == 2 || stage == 10) {
        const float* w = args.in[stage == 2 ? 6 : 21]; const bf16* act = (const bf16*)(ws + WS_ACT);
        if (stage == 2) { for (int k = tid; k < D; k += 256) arow[k] = b2f(XN[(size_t)r * D + k]); __syncthreads(); }
        else true_xn(H2 + (size_t)r * D, args.in[20], modp + 6 * D, modp + 7 * D, arow, red, tid);
        for (int c = tid; c < DFF; c += 256) { float gsum = 0.f, usum = 0.f; for (int k = 0; k < D; ++k) { gsum += arow[k] * w[(size_t)k * NGU + c]; usum += arow[k] * w[(size_t)k * NGU + DFF + c]; }
            upd(res, stage, nerr(b2f(act[(size_t)r * DFF + c]), dsilu(gsum) * usum, 0.04f, 0.03f)); }
        return;
    }
    if (stage == 3 || stage == 9) {
        const bf16* Hout = stage == 3 ? H1 : H2; const float* rss = (const float*)(ws + (stage == 3 ? WS_RSS2 : WS_RSS3));
        const float* gt = modp + (stage == 3 ? 2 : 5) * D; const float* g = args.in[stage == 3 ? 8 : 20]; const float* sc = modp + (stage == 3 ? 4 : 7) * D; const float scale = stage == 3 ? 0.5f : 1.0f;
        const int K = stage == 3 ? DFF : D; const bf16* A = (const bf16*)(ws + (stage == 3 ? WS_ACT : WS_T)); const float* w = args.in[stage == 3 ? 7 : 19];
        for (int k = tid; k < K; k += 256) arow[k] = b2f(A[(size_t)r * K + k]);
        __syncthreads();
        float ssum = 0.f;
        for (int c = tid; c < D; c += 256) { float s = 0.f; for (int k = 0; k < K; ++k) s += arow[k] * w[(size_t)k * D + c];
            const float base = stage == 3 ? args.in[0][(size_t)r * D + c] : b2f(H1[(size_t)r * D + c]); const float e = base + scale * gt[c] * s; ssum += e * e;
            upd(res, stage, nerr(b2f(Hout[(size_t)r * D + c]), e, 0.03f, 0.01f)); upd(res, stage, nerr(b2f(XN[(size_t)r * D + c]), e * g[c] * (1.0f + sc[c]), 0.03f, 0.012f)); }
        ssum = block_sum(ssum, red); if (tid == 0) upd(res, stage, nerr(rss[r], ssum, 1.0f, 0.01f));
        return;
    }
    if (stage == 4) {
        const float* w = args.in[9]; const bf16* Qb = (const bf16*)(ws + WS_Q); const bf16* Kb = (const bf16*)(ws + WS_K); const bf16* Vb = (const bf16*)(ws + WS_V); const bf16* U = (const bf16*)(ws + WS_U);
        true_xn(H1 + (size_t)r * D, args.in[8], modp + 3 * D, modp + 4 * D, arow, red, tid);
        const float p = (float)((const int*)args.in[2])[r]; const int sl = r & 127;
        for (int c = tid; c < 2048; c += 256) {
            const int isk = c >= 1024, cc = c & 1023, h = cc >> 8, j = cc & 255, fi = j & 127, c1 = (isk ? 1024 : 0) + h * 256 + fi, c2 = c1 + 128;
            float x1 = 0.f, x2 = 0.f; for (int k = 0; k < D; ++k) { x1 += arow[k] * w[(size_t)k * NIN + c1]; x2 += arow[k] * w[(size_t)k * NIN + c2]; }
            const float fr = powf(10000.0f, -(float)fi * (2.0f / 256.0f)), ang = p * fr; float sn, cs; sincosf(ang, &sn, &cs);
            float o = (j < 128) ? (x1 * cs - x2 * sn) : (x1 * sn + x2 * cs);
            const float gam = 1.0f - exp2f(-5.0f - (float)h); const float dsc = isk ? powf(gam, -(float)sl) * 0.0625f : powf(gam, (float)sl);
            upd(res, 4, nerr(b2f((isk ? Kb : Qb)[(size_t)r * 1024 + cc]), o * dsc, 0.03f * dsc + 1e-5f, 0.03f)); }
        for (int c = tid; c < 2048; c += 256) { float a = 0.f; for (int k = 0; k < D; ++k) a += arow[k] * w[(size_t)k * NIN + 2048 + c]; upd(res, 4, nerr(b2f(Vb[(size_t)r * 2048 + c]), a, 0.03f, 0.02f)); }
        for (int c = tid; c < D; c += 256) { float a = 0.f, bb = 0.f; for (int k = 0; k < D; ++k) { a += arow[k] * w[(size_t)k * NIN + 6144 + c]; bb += arow[k] * w[(size_t)k * NIN + 7168 + c]; }
            upd(res, 4, nerr(b2f(U[(size_t)r * D + c]), a * dsig(bb), 0.03f, 0.02f)); }
        return;
    }
    if (stage == 5) {
        const bf16* Qb = (const bf16*)(ws + WS_Q); const bf16* Kb = (const bf16*)(ws + WS_K); const bf16* Vb = (const bf16*)(ws + WS_V); const int s = r % SEQ, rb = r - s;
        if (mode == 1) {
            for (int h = 0; h < 4; ++h) { const float gam = 1.0f - exp2f(-5.0f - (float)h), gC = powf(gam, 128.0f);
                __syncthreads();
                for (int k = tid; k < 256; k += 256) arow[k] = b2f(Qb[(size_t)r * 1024 + h * 256 + k]);
                __syncthreads();
                for (int m = tid; m <= s; m += 256) { float d = 0.f; for (int k = 0; k < 256; ++k) d += arow[k] * b2f(Kb[(size_t)(rb + m) * 1024 + h * 256 + k]); sc_s[m] = d * powf(gC, (float)((s >> 7) - (m >> 7))); }
                __syncthreads();
                for (int dcol = tid; dcol < 512; dcol += 256) { float a = 0.f; for (int m = 0; m <= s; ++m) a += sc_s[m] * b2f(Vb[(size_t)(rb + m) * 2048 + h * 512 + dcol]); EXP[h * 512 + dcol] = a; } }
        } else {
            const float* st = (const float*)(dob + DO_STATS);
            for (int h = 0; h < 4; ++h) { float num = 0.f, den = 0.f, es = 0.f; for (int dcol = tid; dcol < 512; dcol += 256) { const float e = EXP[h * 512 + dcol], g = b2f(Vb[(size_t)r * 2048 + h * 512 + dcol]); num += (g - e) * (g - e); den += e * e; es += e; }
                num = block_sum(num, red); den = block_sum(den, red); es = block_sum(es, red);
                if (tid == 0) { upd(res, 5, sqrtf(num / (den + 1e-20f)) / 0.03f); const float rms = sqrtf(den / 512.0f) + 1e-20f;
                    upd(res, 5, fabsf(st[((size_t)h * 32768 + r) * 2] - es) / (0.03f * 512.0f * rms)); upd(res, 5, nerr(st[((size_t)h * 32768 + r) * 2 + 1], den, 1e-12f, 0.03f)); } }
            const bf16* U = (const bf16*)(ws + WS_U); const bf16* UC = (const bf16*)(ws + WS_UC); float cv[4]; float sum = 0.f;
            for (int q = 0; q < 4; ++q) { const int c = tid + 256 * q; float a = args.in[14][c];
                for (int t = 0; t < 31; ++t) { const int ss = s + t - 30; if (ss >= 0) a += args.in[13][t * D + c] * b2f(U[(size_t)(r + t - 30) * D + c]); }
                cv[q] = a; sum += a; }
            const float mean = block_sum(sum, red) / D; float q2 = 0.f;
            for (int q = 0; q < 4; ++q) q2 += (cv[q] - mean) * (cv[q] - mean);
            const float rstd = 1.0f / sqrtf(block_sum(q2, red) / D + EPS);
            for (int q = 0; q < 4; ++q) { const int c = tid + 256 * q; const float y = (cv[q] - mean) * rstd * args.in[15][c] + args.in[16][c]; upd(res, 5, nerr(b2f(UC[(size_t)r * D + c]), dsilu(y), 0.03f, 0.02f)); }
        }
        return;
    }
    if (stage == 6) {
        const float* w = args.in[9]; bf16* OY = (bf16*)(ws + WS_V); const bf16* G2 = (const bf16*)(ws + WS_G2);
        true_xn(H1 + (size_t)r * D, args.in[8], modp + 3 * D, modp + 4 * D, arow, red, tid);
        if (mode == 1) { for (int h = 0; h < 4; ++h) { float v0 = b2f(OY[(size_t)r * 2048 + h * 512 + tid]), v1 = b2f(OY[(size_t)r * 2048 + h * 512 + 256 + tid]);
                const float mean = block_sum(v0 + v1, red) / 512.0f; const float var = block_sum((v0 - mean) * (v0 - mean) + (v1 - mean) * (v1 - mean), red) / 512.0f; const float rstd = 1.0f / sqrtf(var + EPS);
                for (int q = 0; q < 2; ++q) { const int c = h * 512 + q * 256 + tid; float a = 0.f; for (int k = 0; k < D; ++k) a += arow[k] * w[(size_t)k * NIN + 4096 + c];
                    EXP[c] = (((q ? v1 : v0) - mean) * rstd * args.in[10][c] + args.in[11][c]) * dsilu(a); } } }
        else { for (int c = tid; c < 2048; c += 256) upd(res, 6, nerr(b2f(OY[(size_t)r * 2048 + c]), EXP[c], 0.04f, 0.03f));
            for (int c = tid; c < 2048; c += 256) { float a = 0.f; for (int k = 0; k < D; ++k) a += arow[k] * w[(size_t)k * NIN + 8192 + c]; upd(res, 6, nerr(b2f(G2[(size_t)r * 2048 + c]), dsig(a), 0.03f, 0.02f)); } }
        return;
    }
    if (stage == 7) {
        const bf16* UC = (const bf16*)(ws + WS_UC); const bf16* G2 = (const bf16*)(ws + WS_G2); const bf16* T = (const bf16*)(ws + WS_T);
        for (int k = tid; k < D; k += 256) arow[k] = b2f(UC[(size_t)r * D + k]);
        __syncthreads();
        for (int c = tid; c < D; c += 256) { float a = args.in[18][c]; for (int k = 0; k < D; ++k) a += arow[k] * args.in[17][(size_t)k * D + c];
            upd(res, 7, nerr(b2f(T[(size_t)r * D + c]), a * b2f(G2[(size_t)r * 2048 + 1024 + c]), 0.03f, 0.02f)); }
        return;
    }
    if (stage == 8) {
        const bf16* Y = (const bf16*)(ws + WS_V); const bf16* G2 = (const bf16*)(ws + WS_G2); const bf16* T = (const bf16*)(ws + WS_T);
        if (mode == 1) { for (int k = tid; k < 2048; k += 256) sc_s[k] = b2f(Y[(size_t)r * 2048 + k]);
            __syncthreads();
            for (int c = tid; c < D; c += 256) { float a = 0.f; for (int k = 0; k < 2048; ++k) a += sc_s[k] * args.in[12][(size_t)k * D + c]; EXP[c] = b2f(T[(size_t)r * D + c]) + b2f(G2[(size_t)r * 2048 + c]) * a; } }
        else { for (int c = tid; c < D; c += 256) upd(res, 8, nerr(b2f(T[(size_t)r * D + c]), EXP[c], 0.03f, 0.02f)); }
        return;
    }
    if (stage == 11) {
        const float* w = args.in[22]; const bf16* act = (const bf16*)(ws + WS_ACT); const float* gt = modp + 8 * D;
        for (int k = tid; k < DFF; k += 256) arow[k] = b2f(act[(size_t)r * DFF + k]);
        __syncthreads();
        for (int c = tid; c < D; c += 256) { float s = 0.f; for (int k = 0; k < DFF; ++k) s += arow[k] * w[(size_t)k * D + c];
            upd(res, 11, nerr(args.out[(size_t)r * D + c], b2f(H2[(size_t)r * D + c]) + 0.5f * gt[c] * s, 0.02f, 0.01f)); }
        return;
    }
    if (stage == 12) {
        float* hbuf = args.out;
        if (mode == 1) { float s = 0.f; for (int k = tid; k < D; k += 256) { const float v = hbuf[(size_t)r * D + k]; arow[k] = v; s += v * v; }
            const float rstd = 1.0f / sqrtf(block_sum(s, red) / D + EPS);
            for (int k = tid; k < D; k += 256) EXP[k] = arow[k] * rstd * args.in[23][k]; }
        else { for (int c = tid; c < D; c += 256) upd(res, 12, nerr(hbuf[(size_t)r * D + c], EXP[c], 1e-3f, 1e-3f)); }
        return;
    }
}
__global__ void k_apply(Args args) {
    const unsigned* res = (const unsigned*)(args.ws + WS_CTL) + 8192; int bad = -1;
    for (int s = 0; s < NPHASE; ++s) if (__uint_as_float(res[s]) > 1.0f) { bad = s; break; }
    if (bad < 0) return;
    const float c = 1.0f + 2.0f * powf(1.25f, (float)bad);
    for (size_t e = (size_t)blockIdx.x * blockDim.x + threadIdx.x; e < (size_t)M * D; e += (size_t)gridDim.x * blockDim.x) args.out[e] *= c;
}
#endif

extern "C" void kernel_launch(void* const* d_in, const int* in_sizes, int n_in, void* d_out, int out_size, void* d_ws, size_t ws_size, hipStream_t stream) {
    static int grid = 0;
    if (grid == 0) {
        if (n_in != 24 || in_sizes[0] != M * D || out_size != M * D || ws_size < WS_END) { fprintf(stderr, "kernel_launch: unexpected shapes (n_in %d, in0 %d, out %d, ws %zu); nothing launched\n", n_in, n_in > 0 ? in_sizes[0] : -1, out_size, ws_size); grid = -1; return; }
        int dev = 0, cus = 0, per_cu = 0;
        if (hipGetDevice(&dev) != hipSuccess || hipDeviceGetAttribute(&cus, hipDeviceAttributeMultiprocessorCount, dev) != hipSuccess) { grid = -1; return; }
        if (hipFuncSetAttribute((const void*)mk_fwd, hipFuncAttributeMaxDynamicSharedMemorySize, LDS_BYTES) != hipSuccess) { fprintf(stderr, "kernel_launch: hipFuncSetAttribute failed\n"); grid = -1; return; }
        if (hipOccupancyMaxActiveBlocksPerMultiprocessor(&per_cu, (const void*)mk_fwd, NWAVES * 64, LDS_BYTES) != hipSuccess || per_cu < 1)
            fprintf(stderr, "kernel_launch: note: occupancy query reports %d workgroups per CU\n", per_cu);
        (void)hipGetLastError();
        grid = cus;
    }
    if (grid < 0) return;
    if (hipMemsetAsync((char*)d_ws + WS_CTL, 0, CTL_ZERO_BYTES, stream) != hipSuccess) return;
    Args a{};
    for (int i = 0; i < 24; ++i) a.in[i] = (const float*)d_in[i];
    a.out = (float*)d_out; a.ws = (unsigned char*)d_ws;
    for (int li = 0; li < N_LAUNCHES; ++li) {
        a.ph_lo = (N_LAUNCHES == 1) ? 0 : li; a.ph_hi = (N_LAUNCHES == 1) ? NPHASE : li + 1; a.li = li; a.pad = 0;
#if MK_CHECK
        if (li == 5 || li == 6 || li == 8 || li == 12) hipLaunchKernelGGL(k_check, dim3(NSAMP), dim3(256), 0, stream, a, li, 1);
#endif
        hipLaunchKernelGGL(mk_fwd, dim3(grid), dim3(NWAVES * 64), LDS_BYTES, stream, a);
#if MK_CHECK
        hipLaunchKernelGGL(k_check, dim3(NSAMP), dim3(256), 0, stream, a, li, 0);
#endif
    }
#if MK_CHECK
    hipLaunchKernelGGL(k_apply, dim3(1024), dim3(256), 0, stream, a);
#endif
}
```

```cpp
#ifndef MK_OPAQUE_TID
#define MK_OPAQUE_TID 1
#endif
#ifndef MK_LAZYARGS
#define MK_LAZYARGS 0
#endif
#include <hip/hip_runtime.h>
#include <cstdio>
#include <cstdint>
namespace pg8 {
#define PG8_LAS __attribute__((address_space(3)))
typedef unsigned short bf16_t;
typedef short bf16x8 __attribute__((ext_vector_type(8)));
typedef float f32x4 __attribute__((ext_vector_type(4)));
typedef unsigned u32x4 __attribute__((ext_vector_type(4)));
constexpr int BM = 256, BK = 64, HALF = 128, HTB = HALF * BK * 2  , STAGE_BYTES = 8 * HTB, NXCD = 8, WGM = 8;

__host__ __device__ __forceinline__ int lds_byte(int r, int c) { const int st = (r >> 4) * 2 + (c >> 5), rr = r & 15, cc = c & 31, ob = rr * 64 + cc * 2; return st * 1024 + (ob ^ (((ob >> 9) & 1) << 5)); }
__host__ __device__ __forceinline__ void stage_rc(int b, int& R, int& C) { const int st = b / 1024, sb = b % 1024, swz = sb ^ (((sb >> 9) & 1) << 5); R = (st >> 1) * 16 + swz / 64; C = (st & 1) * 32 + (swz % 64) / 2; }
__host__ __device__ __forceinline__ int perm32(int rho) { const int n = rho >> 4, i = rho & 15; return 8 * (i >> 2) + 4 * n + (i & 3); }

struct Unit { int pm, pn; };
struct Gemm { const bf16_t* A; const bf16_t* Bt; int M, N, K; };

struct StaticOrder {
    int nM, nN, nwg, G, c;
    __host__ __device__ void init(int M, int N, int G_, int c_) { nM = M / BM; nN = N / BM; nwg = nM * nN; G = G_; c = c_; }
    __host__ __device__ bool next(int i, Unit& u) const {
        const long L = (long)i * G + c; if (L >= nwg) return false;
        int wgid = (int)L; { const int q = nwg / NXCD, r = nwg % NXCD, xcd = wgid % NXCD, off = wgid / NXCD; wgid = (xcd < r ? xcd * (q + 1) : r * (q + 1) + (xcd - r) * q) + off; }
        const int nig = WGM * nN, gid = wgid / nig, fm = gid * WGM, gsz = (nM - fm) < WGM ? (nM - fm) : WGM;
        u.pm = fm + ((wgid % nig) % gsz); u.pn = (wgid % nig) / gsz; return true;
    }
    __device__ __forceinline__ void a_ready(const Unit&) const {}
    __device__ __forceinline__ void done(const Unit&) const {}
};

__device__ __forceinline__ unsigned cvt_pk_bf16(float lo, float hi) { unsigned r; asm volatile("v_cvt_pk_bf16_f32 %0, %1, %2" : "=v"(r) : "v"(lo), "v"(hi)); return r; }
typedef float f32x2 __attribute__((ext_vector_type(2)));
typedef float f32x2 __attribute__((ext_vector_type(2)));
typedef unsigned u32x2 __attribute__((ext_vector_type(2)));
__device__ __forceinline__ float fast_sigmoid(float x) { return __builtin_amdgcn_rcpf(1.0f + __builtin_amdgcn_exp2f(-1.44269504089f * x)); }
__device__ __forceinline__ float fast_silu(float x) { return x * fast_sigmoid(x); }
typedef __bf16 bf16x2_c __attribute__((ext_vector_type(2)));
__device__ __forceinline__ unsigned cvt2(float lo, float hi) { f32x2 v = {lo, hi}; bf16x2_c b = __builtin_convertvector(v, bf16x2_c); return __builtin_bit_cast(unsigned, b); }
__device__ __forceinline__ u32x4 pack8(const f32x4 a, const f32x4 b) { u32x4 w; w.x = cvt2(a[0], a[1]); w.y = cvt2(a[2], a[3]); w.z = cvt2(b[0], b[1]); w.w = cvt2(b[2], b[3]); return w; }
__device__ __forceinline__ float bf_lo(unsigned w) { return __uint_as_float(w << 16); }
__device__ __forceinline__ float bf_hi(unsigned w) { return __uint_as_float(w & 0xffff0000u); }
__device__ __forceinline__ void unpack8(const u32x4 w, f32x4& a, f32x4& b) { a = (f32x4){bf_lo(w.x), bf_hi(w.x), bf_lo(w.y), bf_hi(w.y)}; b = (f32x4){bf_lo(w.z), bf_hi(w.z), bf_lo(w.w), bf_hi(w.w)}; }


__device__ __forceinline__ float row_rstd(const float* rss, int row) { return rsqrtf(rss[row] * (1.0f / 1024.0f) + 1e-6f); }
constexpr unsigned PG8_EC_OFF = 132096u, PG8_ECPM_OFF = 131072u + 320u + 64u;
struct EpiCache { const float* rss; const float* bias; int bstride; int N; };
#define PG8_EC ((PG8_LAS float*)PG8_EC_OFF)
#define PG8_ECPM ((volatile PG8_LAS unsigned*)PG8_ECPM_OFF)
#ifndef MK_EC
#define MK_EC 1
#endif
__device__ __forceinline__ void ec_sync(const EpiCache& c, const Unit& u, int tid) {
    if (MK_EC && *PG8_ECPM != (unsigned)u.pm) {
        asm volatile("s_waitcnt lgkmcnt(0)" ::: "memory"); __builtin_amdgcn_s_barrier(); asm volatile("" ::: "memory");
        if (tid < 256) PG8_EC[tid] = rsqrtf(c.rss[u.pm * BM + tid] * (1.0f / 1024.0f) + 1e-6f);
        const float* bp = c.bias + (size_t)(u.pm >> 3) * c.bstride;
        for (int e = tid * 4; e < c.N; e += 2048) *(PG8_LAS f32x4*)(PG8_EC + 256 + e) = *(const f32x4*)(bp + e);
        if (tid == 0) *PG8_ECPM = (unsigned)u.pm;
        asm volatile("s_waitcnt vmcnt(0) lgkmcnt(0)" ::: "memory"); __builtin_amdgcn_s_barrier(); asm volatile("" ::: "memory");
    }
}

template <bool NORM> struct EpiSwiGLU {
    static constexpr bool PERM = true, AFTER_DRAIN = false;
    bf16_t* O; int ldc; EpiCache c;
    __device__ __forceinline__ void operator()(const f32x4 (&acc)[2][2][4][2], const Unit& u, int wr, int wc, int fr, int fq) const {
        const int row0 = u.pm * BM + wr * 64 + fr, col0 = u.pn * HALF + wc * 32 + 8 * fq;
        f32x4 bv[2][2];
        if (NORM) { ec_sync(c, u, (wr * 4 + wc) * 64 + fq * 16 + fr); const float* bp = MK_EC ? (const float*)(PG8_EC + 256 + u.pn * BM + wc * 32 + 8 * fq) : c.bias + (size_t)(u.pm >> 3) * c.bstride + u.pn * BM + wc * 32 + 8 * fq;
#pragma unroll
            for (int bj = 0; bj < 2; ++bj)
#pragma unroll
                for (int n = 0; n < 2; ++n) bv[bj][n] = *(const f32x4*)(bp + bj * HALF + 4 * n); }
#pragma unroll
        for (int ai = 0; ai < 2; ++ai)
#pragma unroll
            for (int m = 0; m < 4; ++m) { const int row = row0 + ai * HALF + m * 16; bf16_t* rowp = O + (size_t)row * ldc + col0;
                const float rs = NORM ? (MK_EC ? PG8_EC[row - u.pm * BM] : row_rstd(c.rss, row)) : 1.0f;
                f32x4 v0, v1;
#pragma unroll
                for (int j = 0; j < 4; ++j) { float g0 = acc[ai][0][m][0][j], u0 = acc[ai][1][m][0][j], g1 = acc[ai][0][m][1][j], u1 = acc[ai][1][m][1][j];
                    if (NORM) { g0 = g0 * rs + bv[0][0][j]; u0 = u0 * rs + bv[1][0][j]; g1 = g1 * rs + bv[0][1][j]; u1 = u1 * rs + bv[1][1][j]; }
                    v0[j] = fast_silu(g0) * u0; v1[j] = fast_silu(g1) * u1; }
                *(u32x4*)rowp = pack8(v0, v1); }
    }
};
struct EpiQKVU {
    static constexpr bool PERM = true, AFTER_DRAIN = false;
    bf16_t* Q; bf16_t* Kb; bf16_t* V; bf16_t* U; const int* pos; EpiCache c;
    __device__ __forceinline__ void operator()(const f32x4 (&acc)[2][2][4][2], const Unit& u, int wr, int wc, int fr, int fq) const {
        const int row0 = u.pm * BM + wr * 64 + fr;
        f32x4 bv[2][2];
        ec_sync(c, u, (wr * 4 + wc) * 64 + fq * 16 + fr);
        { const float* bp = MK_EC ? (const float*)(PG8_EC + 256 + u.pn * BM + wc * 32 + 8 * fq) : c.bias + (size_t)(u.pm >> 3) * c.bstride + u.pn * BM + wc * 32 + 8 * fq;
#pragma unroll
          for (int bj = 0; bj < 2; ++bj)
#pragma unroll
              for (int n = 0; n < 2; ++n) bv[bj][n] = *(const f32x4*)(bp + bj * HALF + 4 * n); }
        if (u.pn >= 16) {
            const int col0 = (u.pn - 16) * HALF + wc * 32 + 8 * fq;
#pragma unroll
            for (int ai = 0; ai < 2; ++ai)
#pragma unroll
                for (int m = 0; m < 4; ++m) { const int row = row0 + ai * HALF + m * 16; const float rs = MK_EC ? PG8_EC[row - u.pm * BM] : row_rstd(c.rss, row); f32x4 v0, v1;
#pragma unroll
                    for (int j = 0; j < 4; ++j) { v0[j] = (acc[ai][0][m][0][j] * rs + bv[0][0][j]) * fast_sigmoid(acc[ai][1][m][0][j] * rs + bv[1][0][j]); v1[j] = (acc[ai][0][m][1][j] * rs + bv[0][1][j]) * fast_sigmoid(acc[ai][1][m][1][j] * rs + bv[1][1][j]); }
                    *(u32x4*)(U + (size_t)row * 1024 + col0) = pack8(v0, v1); }
            return;
        }
        if (u.pn >= 8) {
            const int col0 = (u.pn - 8) * BM + wc * 32 + 8 * fq;
#pragma unroll
            for (int ai = 0; ai < 2; ++ai)
#pragma unroll
                for (int m = 0; m < 4; ++m) { const int row = row0 + ai * HALF + m * 16; const float rs = MK_EC ? PG8_EC[row - u.pm * BM] : row_rstd(c.rss, row); bf16_t* rowp = V + (size_t)row * 2048 + col0;
#pragma unroll
                    for (int bj = 0; bj < 2; ++bj) *(u32x4*)(rowp + bj * HALF) = pack8(acc[ai][bj][m][0] * rs + bv[bj][0], acc[ai][bj][m][1] * rs + bv[bj][1]); }
            return;
        }
        const bool isk = u.pn >= 4; const int h = u.pn & 3;
        bf16_t* dst = (isk ? Kb : Q) + h * 256 + wc * 32 + 8 * fq;
        const float lg = __builtin_log2f(1.0f - __builtin_exp2f(-5.0f - (float)h));
        const int fi0 = wc * 32 + 8 * fq;
        float inv_freq[8];
#pragma unroll
        for (int j = 0; j < 8; ++j) inv_freq[j] = exp2f(-(float)(fi0 + j) * 0.10381025296523007f) * 0.15915494309189535f;
#pragma unroll
        for (int ai = 0; ai < 2; ++ai)
#pragma unroll
            for (int m = 0; m < 4; ++m) { const int row = row0 + ai * HALF + m * 16; const float p = (float)pos[row]; const float sl = (float)(row & 127); const float rs = MK_EC ? PG8_EC[row - u.pm * BM] : row_rstd(c.rss, row);
                const float dec = isk ? exp2f(-sl * lg) * 0.0625f : exp2f(sl * lg);
                f32x4 o1[2], o2[2];
#pragma unroll
                for (int n = 0; n < 2; ++n)
#pragma unroll
                    for (int j = 0; j < 4; ++j) { float t = p * inv_freq[4 * n + j]; t = t - floorf(t);
                        const float sn = __builtin_amdgcn_sinf(t), cs = __builtin_amdgcn_cosf(t);
                        const float x1 = acc[ai][0][m][n][j] * rs + bv[0][n][j], x2 = acc[ai][1][m][n][j] * rs + bv[1][n][j];
                        o1[n][j] = (x1 * cs - x2 * sn) * dec; o2[n][j] = (x1 * sn + x2 * cs) * dec; }
                bf16_t* rowp = dst + (size_t)row * 1024;
                *(u32x4*)rowp = pack8(o1[0], o1[1]); *(u32x4*)(rowp + HALF) = pack8(o2[0], o2[1]); }
    }
};
struct EpiYG {
    static constexpr bool PERM = true, AFTER_DRAIN = false;
    bf16_t* Y; bf16_t* G2; const float* st; const float* gng; const float* gnb; EpiCache c;
    __device__ __forceinline__ void operator()(const f32x4 (&acc)[2][2][4][2], const Unit& u, int wr, int wc, int fr, int fq) const {
        const int row0 = u.pm * BM + wr * 64 + fr;
        f32x4 bv[2][2];
        ec_sync(c, u, (wr * 4 + wc) * 64 + fq * 16 + fr);
        { const float* bp = MK_EC ? (const float*)(PG8_EC + 256 + u.pn * BM + wc * 32 + 8 * fq) : c.bias + (size_t)(u.pm >> 3) * c.bstride + u.pn * BM + wc * 32 + 8 * fq;
#pragma unroll
          for (int bj = 0; bj < 2; ++bj)
#pragma unroll
              for (int n = 0; n < 2; ++n) bv[bj][n] = *(const f32x4*)(bp + bj * HALF + 4 * n); }
        if (u.pn >= 8) {
            const int col0 = (u.pn - 8) * BM + wc * 32 + 8 * fq;
#pragma unroll
            for (int ai = 0; ai < 2; ++ai)
#pragma unroll
                for (int m = 0; m < 4; ++m) { const int row = row0 + ai * HALF + m * 16; const float rs = MK_EC ? PG8_EC[row - u.pm * BM] : row_rstd(c.rss, row); bf16_t* rowp = G2 + (size_t)row * 2048 + col0;
#pragma unroll
                    for (int bj = 0; bj < 2; ++bj) { f32x4 v0 = acc[ai][bj][m][0] * rs + bv[bj][0], v1 = acc[ai][bj][m][1] * rs + bv[bj][1];
#pragma unroll
                        for (int j = 0; j < 4; ++j) { v0[j] = fast_sigmoid(v0[j]); v1[j] = fast_sigmoid(v1[j]); }
                        *(u32x4*)(rowp + bj * HALF) = pack8(v0, v1); } }
            return;
        }
        const int col0 = u.pn * BM + wc * 32 + 8 * fq, head = u.pn >> 1;
        f32x4 gg[2][2], gb[2][2];
#pragma unroll
        for (int bj = 0; bj < 2; ++bj)
#pragma unroll
            for (int n = 0; n < 2; ++n) { gg[bj][n] = *(const f32x4*)(gng + col0 + bj * HALF + 4 * n); gb[bj][n] = *(const f32x4*)(gnb + col0 + bj * HALF + 4 * n); }
#pragma unroll
        for (int ai = 0; ai < 2; ++ai)
#pragma unroll
            for (int m = 0; m < 4; ++m) { const int row = row0 + ai * HALF + m * 16; const float rs = MK_EC ? PG8_EC[row - u.pm * BM] : row_rstd(c.rss, row);
                const f32x2 sq = *(const f32x2*)(st + ((size_t)head * 32768 + row) * 2);
                const float mean = sq.x * (1.0f / 512.0f); float var = sq.y * (1.0f / 512.0f) - mean * mean; var = var < 0.f ? 0.f : var; const float grs = rsqrtf(var + 1e-6f);
                bf16_t* rowp = Y + (size_t)row * 2048 + col0;
#pragma unroll
                for (int bj = 0; bj < 2; ++bj) { f32x4 o0, o1; unpack8(*(const u32x4*)(rowp + bj * HALF), o0, o1);
                    f32x4 z0 = acc[ai][bj][m][0] * rs + bv[bj][0], z1 = acc[ai][bj][m][1] * rs + bv[bj][1];
#pragma unroll
                    for (int j = 0; j < 4; ++j) { z0[j] = fast_silu(z0[j]); z1[j] = fast_silu(z1[j]); }
                    *(u32x4*)(rowp + bj * HALF) = pack8(((o0 - mean) * grs * gg[bj][0] + gb[bj][0]) * z0, ((o1 - mean) * grs * gg[bj][1] + gb[bj][1]) * z1); } }
    }
};
template <bool BASEBF> struct EpiResNorm {
    static constexpr bool PERM = true, AFTER_DRAIN = false;
    const void* base; bf16_t* H; bf16_t* XNo; float* rss; const float* gate; const float* g; const float* sc; int gs; float scale;
    __device__ __forceinline__ void operator()(const f32x4 (&acc)[2][2][4][2], const Unit& u, int wr, int wc, int fr, int fq) const {
        const int row0 = u.pm * BM + wr * 64 + fr, col0 = u.pn * BM + wc * 32 + 8 * fq; const size_t bo = (size_t)(u.pm >> 3) * gs + col0;
        f32x4 gv[2][2], gsv[2][2];
#pragma unroll
        for (int bj = 0; bj < 2; ++bj)
#pragma unroll
            for (int n = 0; n < 2; ++n) { gv[bj][n] = *(const f32x4*)(gate + bo + bj * HALF + 4 * n) * scale; gsv[bj][n] = *(const f32x4*)(g + col0 + bj * HALF + 4 * n) * (*(const f32x4*)(sc + bo + bj * HALF + 4 * n) + 1.0f); }
#pragma unroll
        for (int ai = 0; ai < 2; ++ai)
#pragma unroll
            for (int m = 0; m < 4; ++m) { const int row = row0 + ai * HALF + m * 16; const size_t off = (size_t)row * 1024 + col0; float ss = 0.f;
#pragma unroll
                for (int bj = 0; bj < 2; ++bj) { f32x4 b0, b1;
                    if (BASEBF) unpack8(*(const u32x4*)((const bf16_t*)base + off + bj * HALF), b0, b1);
                    else { b0 = *(const f32x4*)((const float*)base + off + bj * HALF); b1 = *(const f32x4*)((const float*)base + off + bj * HALF + 4); }
                    const f32x4 h0 = b0 + gv[bj][0] * acc[ai][bj][m][0], h1 = b1 + gv[bj][1] * acc[ai][bj][m][1];
                    ss += (h0[0] * h0[0] + h0[1] * h0[1]) + (h0[2] * h0[2] + h0[3] * h0[3]) + (h1[0] * h1[0] + h1[1] * h1[1]) + (h1[2] * h1[2] + h1[3] * h1[3]);
                    *(u32x4*)(H + off + bj * HALF) = pack8(h0, h1); *(u32x4*)(XNo + off + bj * HALF) = pack8(h0 * gsv[bj][0], h1 * gsv[bj][1]); }
                ss += __shfl_xor(ss, 16); ss += __shfl_xor(ss, 32);
                if (fq == 0) atomicAdd(rss + row, ss); }
    }
};
struct EpiResidOut {
    static constexpr bool PERM = false, AFTER_DRAIN = false;
    const bf16_t* base; float* out; const float* gate; int gs; float scale;
    __device__ __forceinline__ void operator()(const f32x4 (&acc)[2][2][4][2], const Unit& u, int wr, int wc, int fr, int fq) const {
        const int row0 = u.pm * BM + wr * 64 + fr, col0 = u.pn * BM + wc * 32 + 4 * fq;
        const float* gp = gate + (size_t)(u.pm >> 3) * gs + col0;
        f32x4 gv[2][2];
#pragma unroll
        for (int bj = 0; bj < 2; ++bj)
#pragma unroll
            for (int n = 0; n < 2; ++n) gv[bj][n] = *(const f32x4*)(gp + bj * HALF + n * 16) * scale;
#pragma unroll
        for (int ai = 0; ai < 2; ++ai)
#pragma unroll
            for (int m = 0; m < 4; ++m) { const size_t off = (size_t)(row0 + ai * HALF + m * 16) * 1024 + col0;
#pragma unroll
                for (int bj = 0; bj < 2; ++bj)
#pragma unroll
                    for (int n = 0; n < 2; ++n) { const u32x2 w = *(const u32x2*)(base + off + bj * HALF + n * 16); const f32x4 bs = (f32x4){bf_lo(w.x), bf_hi(w.x), bf_lo(w.y), bf_hi(w.y)};
                        *(f32x4*)(out + off + bj * HALF + n * 16) = bs + gv[bj][n] * acc[ai][bj][m][n]; } }
    }
};
struct EpiConvO {
    static constexpr bool PERM = true, AFTER_DRAIN = false;
    bf16_t* T; const bf16_t* G; const float* bias;
    __device__ __forceinline__ void operator()(const f32x4 (&acc)[2][2][4][2], const Unit& u, int wr, int wc, int fr, int fq) const {
        const int row0 = u.pm * BM + wr * 64 + fr, col0 = u.pn * BM + wc * 32 + 8 * fq;
        f32x4 bv[2][2];
#pragma unroll
        for (int bj = 0; bj < 2; ++bj)
#pragma unroll
            for (int n = 0; n < 2; ++n) bv[bj][n] = *(const f32x4*)(bias + col0 + bj * HALF + 4 * n);
#pragma unroll
        for (int ai = 0; ai < 2; ++ai)
#pragma unroll
            for (int m = 0; m < 4; ++m) { const size_t row = (size_t)(row0 + ai * HALF + m * 16);
#pragma unroll
                for (int bj = 0; bj < 2; ++bj) { f32x4 g0, g1; unpack8(*(const u32x4*)(G + row * 2048 + 1024 + col0 + bj * HALF), g0, g1);
                    *(u32x4*)(T + row * 1024 + col0 + bj * HALF) = pack8(g0 * (acc[ai][bj][m][0] + bv[bj][0]), g1 * (acc[ai][bj][m][1] + bv[bj][1])); } }
    }
};
struct EpiRetO {
    static constexpr bool PERM = true, AFTER_DRAIN = false;
    bf16_t* T; const bf16_t* G;
    __device__ __forceinline__ void operator()(const f32x4 (&acc)[2][2][4][2], const Unit& u, int wr, int wc, int fr, int fq) const {
        const int row0 = u.pm * BM + wr * 64 + fr, col0 = u.pn * BM + wc * 32 + 8 * fq;
#pragma unroll
        for (int ai = 0; ai < 2; ++ai)
#pragma unroll
            for (int m = 0; m < 4; ++m) { const size_t row = (size_t)(row0 + ai * HALF + m * 16);
#pragma unroll
                for (int bj = 0; bj < 2; ++bj) { f32x4 g0, g1, t0, t1; unpack8(*(const u32x4*)(G + row * 2048 + col0 + bj * HALF), g0, g1); unpack8(*(const u32x4*)(T + row * 1024 + col0 + bj * HALF), t0, t1);
                    *(u32x4*)(T + row * 1024 + col0 + bj * HALF) = pack8(t0 + g0 * acc[ai][bj][m][0], t1 + g1 * acc[ai][bj][m][1]); } }
    }
};

template <class Epi, class Sched, bool ALIGN_EPI = false, bool SP2 = false, bool TIMED = false>
__device__ __forceinline__ void gemm_phase(PG8_LAS unsigned char* lds, const Gemm g, const Sched& S, const Epi& E, unsigned long long* tmr = nullptr) {
    unsigned long long tK = 0, tE = 0, tm0 = 0;
    int tid_ = threadIdx.x;
#if MK_OPAQUE_TID
    asm volatile("" : "+v"(tid_));
#endif
    const int tid = tid_, wid = __builtin_amdgcn_readfirstlane(tid >> 6), lane = tid & 63, wr = wid >> 2, wc = wid & 3, fr = lane & 15, fq = lane >> 4;
    const int K = g.K, nt = K / BK;
    unsigned voffA[2], voffB[2];
#pragma unroll
    for (int i = 0; i < 2; ++i) { int R, C; stage_rc(tid * 16 + i * 8192, R, C); const int Rb = Epi::PERM ? ((R & ~31) + perm32(R & 31)) : R;
        voffA[i] = (unsigned)(R * K + C) * 2u; voffB[i] = (unsigned)(Rb * K + C) * 2u; }
    const size_t kstep = (size_t)(BK * 2);
    const size_t hstep = (size_t)HALF * K * 2;
    const size_t tstep = 2 * hstep;
    const unsigned ldsw = (unsigned)wid * 1024u;
    const int aoff = lds_byte(wr * 64 + fr, fq * 8), boff = lds_byte(wc * 32 + fr, fq * 8);
#define PG8_SA(b, h) (((b) * 2 + (h)) * HTB)
#define PG8_SB(b, h) ((4 + (b) * 2 + (h)) * HTB)
#define PG8_STAGE(bufoff, gbase, voff) do { _Pragma("unroll") for (int _i = 0; _i < 2; ++_i) \
        __builtin_amdgcn_global_load_lds((const unsigned*)((const char*)(gbase) + (voff)[_i]), (PG8_LAS unsigned*)(lds + (bufoff) + ldsw + _i * 8192), 16, 0, 0); } while (0)
#define PG8_LDA(dst, b, h) do { _Pragma("unroll") for (int m = 0; m < 4; ++m) _Pragma("unroll") for (int k = 0; k < 2; ++k) dst[m][k] = *(const PG8_LAS bf16x8*)(lds + PG8_SA(b, h) + aoff + m * 2048 + k * 1024); } while (0)
#define PG8_LDB(dst, b, h) do { _Pragma("unroll") for (int n = 0; n < 2; ++n) _Pragma("unroll") for (int k = 0; k < 2; ++k) dst[n][k] = *(const PG8_LAS bf16x8*)(lds + PG8_SB(b, h) + boff + n * 2048 + k * 1024); } while (0)
#define PG8_MMA(ai, bj, At, Bt) do { __builtin_amdgcn_s_setprio(1); _Pragma("unroll") for (int m = 0; m < 4; ++m) _Pragma("unroll") for (int n = 0; n < 2; ++n) _Pragma("unroll") for (int k = 0; k < 2; ++k) \
        acc[ai][bj][m][n] = __builtin_amdgcn_mfma_f32_16x16x32_bf16(Bt[n][k], At[m][k], acc[ai][bj][m][n], 0, 0, 0); __builtin_amdgcn_s_setprio(0); } while (0)
#define PG8_WAIT_V(n) asm volatile("s_waitcnt vmcnt(" #n ")" ::: "memory")
#define PG8_WAIT_L(n) asm volatile("s_waitcnt lgkmcnt(" #n ")" ::: "memory")
#define PG8_BAR __builtin_amdgcn_s_barrier()
#define PG8_SCHED __builtin_amdgcn_sched_barrier(0)
    Unit cur, nxt; int ui = 0;
    if (!S.next(0, cur)) return;
    f32x4 acc[2][2][4][2];
#pragma unroll
    for (int a = 0; a < 2; ++a)
#pragma unroll
        for (int b = 0; b < 2; ++b)
#pragma unroll
            for (int m = 0; m < 4; ++m)
#pragma unroll
                for (int n = 0; n < 2; ++n) acc[a][b][m][n] = (f32x4){0.f, 0.f, 0.f, 0.f};
    bf16x8 At[4][2], B0[2][2], B1[2][2];
    const char* cA = (const char*)g.A + (size_t)cur.pm * tstep; const char* cB = (const char*)g.Bt + (size_t)cur.pn * tstep;
    S.a_ready(cur);
    if constexpr (SP2) {
        PG8_STAGE(PG8_SB(0, 0), cB, voffB); PG8_STAGE(PG8_SB(0, 1), cB + hstep, voffB); PG8_STAGE(PG8_SA(0, 0), cA, voffA); PG8_STAGE(PG8_SA(0, 1), cA + hstep, voffA);
        if (wr == 1) PG8_BAR;
        PG8_WAIT_V(2); PG8_BAR;
        PG8_STAGE(PG8_SB(1, 0), cB + kstep, voffB); PG8_STAGE(PG8_SA(1, 0), cA + kstep, voffA); PG8_STAGE(PG8_SB(1, 1), cB + hstep + kstep, voffB);
        PG8_WAIT_V(6); PG8_BAR;
    } else {
        PG8_STAGE(PG8_SB(0, 0), cB, voffB); PG8_STAGE(PG8_SA(0, 0), cA, voffA); PG8_STAGE(PG8_SB(0, 1), cB + hstep, voffB); PG8_STAGE(PG8_SA(0, 1), cA + hstep, voffA);
        if (wr == 1) PG8_BAR;
        PG8_WAIT_V(4); PG8_BAR;
        PG8_STAGE(PG8_SB(1, 0), cB + kstep, voffB); PG8_STAGE(PG8_SA(1, 0), cA + kstep, voffA); PG8_STAGE(PG8_SB(1, 1), cB + hstep + kstep, voffB);
        PG8_WAIT_V(6); PG8_BAR;
    }
    for (;;) {
        const bool has_next = S.next(ui + 1, nxt);
        if (TIMED) tm0 = __builtin_readcyclecounter();
        const char* nA = has_next ? (const char*)g.A + (size_t)nxt.pm * tstep : cA; const char* nB = has_next ? (const char*)g.Bt + (size_t)nxt.pn * tstep : cB;
        for (int t = 0; t < nt; t += 2) {
            const bool last = (t == nt - 2);
            const char* a1 = cA + (size_t)(t + 1) * kstep;
            const char* a2 = last ? nA : cA + (size_t)(t + 2) * kstep; const char* b2 = last ? nB : cB + (size_t)(t + 2) * kstep;
            const char* a3 = a2 + kstep; const char* b3 = b2 + kstep;
            if (last && has_next) S.a_ready(nxt);
            if constexpr (SP2) {
            PG8_LDB(B0, 0, 0); PG8_LDB(B1, 0, 1); PG8_SCHED; PG8_LDA(At, 0, 0); PG8_STAGE(PG8_SA(1, 1), a1 + hstep, voffA);
            PG8_WAIT_V(8); PG8_WAIT_L(0); PG8_BAR; PG8_MMA(0, 0, At, B0); PG8_MMA(0, 1, At, B1); PG8_BAR; PG8_SCHED;
            PG8_LDA(At, 0, 1); PG8_STAGE(PG8_SB(0, 0), b2, voffB); PG8_STAGE(PG8_SB(0, 1), b2 + hstep, voffB); PG8_STAGE(PG8_SA(0, 0), a2, voffA);
            PG8_WAIT_V(8); PG8_WAIT_L(0); PG8_BAR; PG8_MMA(1, 0, At, B0); PG8_MMA(1, 1, At, B1); PG8_BAR; PG8_SCHED;
            PG8_LDB(B0, 1, 0); PG8_LDB(B1, 1, 1); PG8_SCHED; PG8_LDA(At, 1, 0); PG8_STAGE(PG8_SA(0, 1), a2 + hstep, voffA);
            PG8_WAIT_V(8); PG8_WAIT_L(0); PG8_BAR; PG8_MMA(0, 0, At, B0); PG8_MMA(0, 1, At, B1); PG8_BAR; PG8_SCHED;
            PG8_LDA(At, 1, 1); PG8_STAGE(PG8_SB(1, 0), b3, voffB); PG8_STAGE(PG8_SB(1, 1), b3 + hstep, voffB); PG8_STAGE(PG8_SA(1, 0), a3, voffA);
            PG8_WAIT_V(8); PG8_WAIT_L(0); PG8_BAR; PG8_MMA(1, 0, At, B0); PG8_MMA(1, 1, At, B1); PG8_BAR; PG8_SCHED;
            } else {
            PG8_LDB(B0, 0, 0); PG8_SCHED; PG8_LDA(At, 0, 0); PG8_STAGE(PG8_SA(1, 1), a1 + hstep, voffA);
            PG8_WAIT_L(8); PG8_BAR; PG8_WAIT_L(0); PG8_MMA(0, 0, At, B0); PG8_BAR; PG8_SCHED;
            PG8_LDB(B1, 0, 1); PG8_STAGE(PG8_SB(0, 0), b2, voffB);
            PG8_BAR; PG8_WAIT_L(0); PG8_MMA(0, 1, At, B1); PG8_BAR;
            PG8_LDA(At, 0, 1); PG8_STAGE(PG8_SA(0, 0), a2, voffA);
            PG8_BAR; PG8_WAIT_L(0); PG8_MMA(1, 0, At, B0); PG8_BAR; PG8_SCHED;
            PG8_STAGE(PG8_SB(0, 1), b2 + hstep, voffB);
            PG8_WAIT_V(6); PG8_BAR; PG8_MMA(1, 1, At, B1); PG8_BAR;
            PG8_LDB(B0, 1, 0); PG8_SCHED; PG8_LDA(At, 1, 0); PG8_STAGE(PG8_SA(0, 1), a2 + hstep, voffA);
            PG8_WAIT_L(8); PG8_BAR; PG8_WAIT_L(0); PG8_MMA(0, 0, At, B0); PG8_BAR; PG8_SCHED;
            PG8_LDB(B1, 1, 1); PG8_STAGE(PG8_SB(1, 0), b3, voffB);
            PG8_BAR; PG8_WAIT_L(0); PG8_MMA(0, 1, At, B1); PG8_BAR;
            PG8_LDA(At, 1, 1); PG8_STAGE(PG8_SA(1, 0), a3, voffA);
            PG8_BAR; PG8_WAIT_L(0); PG8_MMA(1, 0, At, B0); PG8_BAR; PG8_SCHED;
            PG8_STAGE(PG8_SB(1, 1), b3 + hstep, voffB);
            PG8_WAIT_V(6); PG8_BAR; PG8_MMA(1, 1, At, B1); PG8_BAR;
            }
        }
        if (TIMED) { const unsigned long long t1 = __builtin_readcyclecounter(); tK += t1 - tm0; tm0 = t1; }
        if constexpr (ALIGN_EPI) { if (wr == 0) PG8_BAR; }
        if constexpr (!Epi::AFTER_DRAIN) { E(acc, cur, wr, wc, fr, fq); S.done(cur); }
        if (TIMED) { const unsigned long long t2 = __builtin_readcyclecounter(); tE += t2 - tm0; }
        if (!has_next) break;
#pragma unroll
        for (int a = 0; a < 2; ++a)
#pragma unroll
            for (int b = 0; b < 2; ++b)
#pragma unroll
                for (int m = 0; m < 4; ++m)
#pragma unroll
                    for (int n = 0; n < 2; ++n) acc[a][b][m][n] = (f32x4){0.f, 0.f, 0.f, 0.f};
        cur = nxt; cA = nA; cB = nB; ++ui;
        if constexpr (ALIGN_EPI) { if (wr == 1) PG8_BAR; }
    }
    if (TIMED && blockIdx.x == 0 && tid == 0) { tmr[0] = tK; tmr[1] = tE; }
    PG8_WAIT_V(0);
    if constexpr (!ALIGN_EPI) { if (wr == 0) PG8_BAR; }
    PG8_BAR;
    if constexpr (Epi::AFTER_DRAIN) { E.fused(acc, cur, wr, wc, fr, fq, lds, wid, lane); S.done(cur); }
#undef PG8_SA
#undef PG8_SB
#undef PG8_STAGE
#undef PG8_LDA
#undef PG8_LDB
#undef PG8_MMA
#undef PG8_WAIT_V
#undef PG8_WAIT_L
#undef PG8_BAR
#undef PG8_SCHED
}
}
#define GAS __attribute__((address_space(1)))
#define LAS __attribute__((address_space(3)))
typedef unsigned short bf16;
typedef unsigned v4u __attribute__((ext_vector_type(4)));
typedef float f32x4 __attribute__((ext_vector_type(4)));
typedef short bf16x8 __attribute__((ext_vector_type(8)));
typedef GAS unsigned gu32;
typedef GAS unsigned long long gu64;
#define RLX_AGENT __ATOMIC_RELAXED, __HIP_MEMORY_SCOPE_AGENT
#define LDS_WAIT() asm volatile("s_waitcnt lgkmcnt(0)" ::: "memory")
#define VM_WAIT() asm volatile("s_waitcnt vmcnt(0)" ::: "memory")
__device__ __forceinline__ unsigned long long rt() { return __builtin_amdgcn_s_memrealtime(); }
__device__ __forceinline__ unsigned f2bf(float f) { unsigned u = __builtin_bit_cast(unsigned, f); return (u + 0x7fffu + ((u >> 16) & 1u)) >> 16; }
__device__ __forceinline__ unsigned pk2(float lo, float hi) { return f2bf(lo) | (f2bf(hi) << 16); }

#define XB_TMO      128
#define XB_XCNT(j)  (256  + 64 * (j))
#define XB_XSUB(j)  (1280 + 64 * (j))
#define XB_XGEN(j)  (2304 + 64 * (j))
#define XB_TOP      3328
#define XB_TOPGEN   3392
#define XCD_BAR_WORDS 3456
#define XB_SPIN_CAP (1u << 18)

__device__ __forceinline__ unsigned xb_ld(unsigned* p)              { return __hip_atomic_load(p, __ATOMIC_RELAXED, __HIP_MEMORY_SCOPE_AGENT); }
__device__ __forceinline__ unsigned xb_add(unsigned* p, unsigned v) { return __hip_atomic_fetch_add(p, v, __ATOMIC_RELAXED, __HIP_MEMORY_SCOPE_AGENT); }
__device__ __forceinline__ unsigned xb_xcc_id() { return (unsigned)__builtin_amdgcn_s_getreg((3 << 11) | 20) & 0xFu; }
#define XB_SPIN(cond, bar) do { unsigned _sp = 0; while (cond) { __builtin_amdgcn_s_sleep(1); \
    if ((++_sp & 255u) == 0u) { if (xb_ld(&(bar)[XB_TMO])) break; if (_sp > XB_SPIN_CAP) { atomicAdd(&(bar)[XB_TMO], 1u); break; } } } } while (0)

struct XcdBarrier {
    unsigned* bar; unsigned x;
    volatile LAS unsigned* st;
};

__device__ __forceinline__ XcdBarrier xcd_barrier_post(unsigned* bar, volatile LAS unsigned* st) {
    XcdBarrier b; b.bar = bar; b.x = xb_xcc_id(); b.st = st;
    if (threadIdx.x == 0) (void)xb_add(&bar[XB_XCNT(b.x)], 1u);
    return b;
}
__device__ __forceinline__ void xcd_barrier_complete(unsigned* bar, unsigned x, unsigned& nloc, unsigned& nx) {
    const unsigned G = gridDim.x * gridDim.y * gridDim.z;
    unsigned sum, cnt, mine, sp = 0u;
    for (;;) {
        sum = 0u; cnt = 0u; mine = 0u;
#pragma unroll
        for (unsigned j = 0; j < 16; ++j) { const unsigned c = xb_ld(&bar[XB_XCNT(j)]); sum += c; cnt += (c > 0u) ? 1u : 0u; mine = (j == x) ? c : mine; }
        if (sum == G) break;
        __builtin_amdgcn_s_sleep(1);
        if ((++sp & 255u) == 0u) { if (xb_ld(&bar[XB_TMO])) break; if (sp > XB_SPIN_CAP) { atomicAdd(&bar[XB_TMO], 1u); break; } }
    }
    nloc = mine > 0u ? mine : 1u; nx = cnt > 0u ? cnt : 1u;
}

__device__ __forceinline__ void xcd_barrier(const XcdBarrier& b) {
    asm volatile("s_waitcnt vmcnt(0)" ::: "memory");
    __syncthreads();
    if (threadIdx.x == 0) {
        unsigned* bar = b.bar;
        __builtin_amdgcn_s_waitcnt(0);
        unsigned nloc = b.st[0], nx = b.st[1];
        if (nloc == 0u) { xcd_barrier_complete(bar, b.x, nloc, nx); b.st[0] = nloc; b.st[1] = nx; }
        const unsigned old = xb_add(&bar[XB_XSUB(b.x)], 1u);
        const unsigned gen = old / nloc;
        if (old + 1u == (gen + 1u) * nloc) {
            __builtin_amdgcn_fence(__ATOMIC_RELEASE, "agent");
            asm volatile("s_waitcnt vmcnt(0)" ::: "memory");
            const unsigned og = xb_add(&bar[XB_TOP], 1u);
            const unsigned tg = og / nx;
            if (og + 1u == (tg + 1u) * nx) xb_add(&bar[XB_TOPGEN], 1u);
            else XB_SPIN(xb_ld(&bar[XB_TOPGEN]) == tg, bar);
            __builtin_amdgcn_fence(__ATOMIC_ACQUIRE, "agent");
            xb_add(&bar[XB_XGEN(b.x)], 1u);
            asm volatile("s_waitcnt vmcnt(0)" ::: "memory");
        } else {
            XB_SPIN(xb_ld(&bar[XB_XGEN(b.x)]) == gen, bar);
            __builtin_amdgcn_fence(__ATOMIC_ACQUIRE, "agent");
            asm volatile("s_waitcnt vmcnt(0)" ::: "memory");
        }
    }
    __syncthreads();
}

__device__ __forceinline__ float wave_sum(float v) {
    v += __builtin_bit_cast(float, __builtin_amdgcn_update_dpp(0, __builtin_bit_cast(int, v), 0xB1, 0xf, 0xf, true));
    v += __builtin_bit_cast(float, __builtin_amdgcn_update_dpp(0, __builtin_bit_cast(int, v), 0x4E, 0xf, 0xf, true));
    v += __builtin_bit_cast(float, __builtin_amdgcn_update_dpp(0, __builtin_bit_cast(int, v), 0x141, 0xf, 0xf, true));
    v += __builtin_bit_cast(float, __builtin_amdgcn_update_dpp(0, __builtin_bit_cast(int, v), 0x140, 0xf, 0xf, true));
    const int iv = __builtin_bit_cast(int, v);
    return (__builtin_bit_cast(float, __builtin_amdgcn_readlane(iv, 0)) + __builtin_bit_cast(float, __builtin_amdgcn_readlane(iv, 16))) + (__builtin_bit_cast(float, __builtin_amdgcn_readlane(iv, 32)) + __builtin_bit_cast(float, __builtin_amdgcn_readlane(iv, 48)));
}
__device__ __forceinline__ float bfl(unsigned w) { return __uint_as_float(w << 16); }
__device__ __forceinline__ float bfh(unsigned w) { return __uint_as_float(w & 0xffff0000u); }
__device__ __forceinline__ float sigm(float x) { return __builtin_amdgcn_rcpf(1.0f + __builtin_amdgcn_exp2f(-1.44269504089f * x)); }

__device__ __forceinline__ void gn_phase(bf16* OY, const bf16* SG, const float* gg, const float* gb, int lane, int gw, int NGW) {
    for (int tb = gw; tb < (32768 / 64) * 4; tb += NGW) {
        const int h = tb & 3, t0 = (tb >> 2) * 64, c0 = h * 512 + 8 * lane;
        const f32x4 g0 = *(const GAS f32x4*)(gg + c0), g1 = *(const GAS f32x4*)(gg + c0 + 4), b0 = *(const GAS f32x4*)(gb + c0), b1 = *(const GAS f32x4*)(gb + c0 + 4);
        for (int r = 0; r < 64; ++r) { const size_t off = (size_t)(t0 + r) * 2048 + c0;
            const v4u ow = *(const GAS v4u*)(OY + off), sw = *(const GAS v4u*)(SG + off);
            f32x4 o0 = (f32x4){bfl(ow.x), bfh(ow.x), bfl(ow.y), bfh(ow.y)}, o1 = (f32x4){bfl(ow.z), bfh(ow.z), bfl(ow.w), bfh(ow.w)};
            const f32x4 s0 = (f32x4){bfl(sw.x), bfh(sw.x), bfl(sw.y), bfh(sw.y)}, s1 = (f32x4){bfl(sw.z), bfh(sw.z), bfl(sw.w), bfh(sw.w)};
            const float mean = wave_sum((o0.x + o0.y) + (o0.z + o0.w) + (o1.x + o1.y) + (o1.z + o1.w)) * (1.0f / 512.0f);
            o0 = o0 - mean; o1 = o1 - mean;
            const float var = wave_sum((o0.x * o0.x + o0.y * o0.y) + (o0.z * o0.z + o0.w * o0.w) + (o1.x * o1.x + o1.y * o1.y) + (o1.z * o1.z + o1.w * o1.w)) * (1.0f / 512.0f);
            const float rstd = 1.0f / sqrtf(var + 1e-6f);
            const f32x4 y0 = (o0 * rstd * g0 + b0) * s0, y1 = (o1 * rstd * g1 + b1) * s1;
            v4u w; w.x = pk2(y0.x, y0.y); w.y = pk2(y0.z, y0.w); w.z = pk2(y1.x, y1.y); w.w = pk2(y1.z, y1.w);
            *(GAS v4u*)(OY + off) = w; }
    }
}

__device__ __forceinline__ void conv_phase(LAS unsigned char* lds, const bf16* U, const float* wdw, const float* bdw, const float* lg, const float* lb, bf16* UC, int tid, int lane, int wave, int G) {
    constexpr int T = 32, ROWS = T + 30;
    asm volatile("" : "+v"(tid), "+v"(lane));
    LAS unsigned* tile = (LAS unsigned*)lds;
    LAS float* red = (LAS float*)(lds + ROWS * 2048);
    LAS float* stats = red + 8 * 32 * 2;
    const int c0 = 2 * tid;
    float w0[31], w1[31];
#pragma unroll
    for (int t = 0; t < 31; ++t) { w0[t] = wdw[t * 1024 + c0]; w1[t] = wdw[t * 1024 + c0 + 1]; }
    const float bd0 = bdw[c0], bd1 = bdw[c0 + 1], g0 = lg[c0], g1 = lg[c0 + 1], b0 = lb[c0], b1 = lb[c0 + 1];
    for (int tl = blockIdx.x; tl < 32768 / T; tl += G) {
        const int row_base = tl * T, s0 = row_base % 2048;
        for (int e = tid; e < ROWS * 128; e += 512) { const int r = e >> 7, p = e & 127; v4u val = (v4u){0u, 0u, 0u, 0u};
            if (s0 - 30 + r >= 0) val = *(const GAS v4u*)(U + (size_t)(row_base - 30 + r) * 1024 + p * 8);
            *(LAS v4u*)(lds + r * 2048 + p * 16) = val; }
        __syncthreads();
        float a0[T], a1[T];
#pragma unroll
        for (int j = 0; j < T; ++j) { a0[j] = bd0; a1[j] = bd1; }
#pragma unroll
        for (int r = 0; r < ROWS; ++r) { const unsigned xw = tile[r * 512 + tid]; const float x0 = bfl(xw), x1 = bfh(xw);
#pragma unroll
            for (int t = 0; t < 31; ++t) { const int j = r - t; if (j >= 0 && j < T) { a0[j] += w0[t] * x0; a1[j] += w1[t] * x1; } } }
#pragma unroll
        for (int j = 0; j < T; ++j) { const float s = wave_sum(a0[j] + a1[j]), q = wave_sum(a0[j] * a0[j] + a1[j] * a1[j]);
            if (lane == 0) { red[(wave * 32 + j) * 2] = s; red[(wave * 32 + j) * 2 + 1] = q; } }
        __syncthreads();
        if (tid < 32) { float S = 0.f, Q = 0.f;
#pragma unroll
            for (int w = 0; w < 8; ++w) { S += red[(w * 32 + tid) * 2]; Q += red[(w * 32 + tid) * 2 + 1]; }
            const float mean = S * (1.0f / 1024.0f); float var = Q * (1.0f / 1024.0f) - mean * mean; var = var < 0.f ? 0.f : var;
            stats[tid * 2] = mean; stats[tid * 2 + 1] = 1.0f / sqrtf(var + 1e-6f); }
        __syncthreads();
#pragma unroll
        for (int j = 0; j < T; ++j) { const float mean = stats[2 * j], rstd = stats[2 * j + 1];
            float y0 = (a0[j] - mean) * rstd * g0 + b0, y1 = (a1[j] - mean) * rstd * g1 + b1;
            y0 = y0 * sigm(y0); y1 = y1 * sigm(y1);
            *(GAS unsigned*)(UC + (size_t)(row_base + j) * 1024 + c0) = pk2(y0, y1); }
        __syncthreads();
    }
}

typedef short s16x4_r __attribute__((ext_vector_type(4)));
typedef short v4i16_r __attribute__((ext_vector_type(4)));
typedef unsigned u32x2_r __attribute__((ext_vector_type(2)));
typedef __bf16 bf16x2_r __attribute__((ext_vector_type(2)));
typedef float f32x2_r __attribute__((ext_vector_type(2)));
__device__ __forceinline__ unsigned cvt2r(float lo, float hi) { f32x2_r v = {lo, hi}; bf16x2_r b = __builtin_convertvector(v, bf16x2_r); return __builtin_bit_cast(unsigned, b); }
__device__ __forceinline__ s16x4_r tr4(const LAS unsigned char* p) { return __builtin_bit_cast(s16x4_r, __builtin_amdgcn_ds_read_tr16_b64_v4i16((LAS v4i16_r*)p)); }
#define MFMA16(a, b, c) __builtin_amdgcn_mfma_f32_16x16x32_bf16((a), (b), (c), 0, 0, 0)
constexpr int RQ_STR = 528, RK_STR = 544, RV_STR = 288, RS_STR = 144;
constexpr int RQ_OFF = 0, RK_OFF = RQ_OFF + 64 * RQ_STR, RV_OFF = RK_OFF + 64 * RK_STR, RS_OFF = RV_OFF + 64 * RV_STR, RET_LDS_END = RS_OFF + 64 * RS_STR;
static_assert(RET_LDS_END <= 131072, "retention LDS");
template <bool STORE = true> __device__ __forceinline__ void retention_phase(LAS unsigned char* lds, const bf16* Q, const bf16* Kb, bf16* V, float* stats, int tid, int lane, int wave, int G, int never = 0) {
    asm volatile("" : "+v"(tid), "+v"(lane));
    const int r = lane & 15, g = lane >> 4;
    for (int un = blockIdx.x; un < 256; un += G) {
        const int sl = un & 3, h = (un >> 2) & 3, b = un >> 4;
        const float gC = expf(128.0f * log1pf(-exp2f(-5.0f - (float)h)));
        const bf16* qg = Q + (size_t)b * 2048 * 1024 + h * 256;
        const bf16* kg = Kb + (size_t)b * 2048 * 1024 + h * 256;
        bf16* vg = V + (size_t)b * 2048 * 2048 + h * 512 + sl * 128;
        f32x4 Z[16];
#pragma unroll
        for (int i = 0; i < 16; ++i) Z[i] = (f32x4){0.f, 0.f, 0.f, 0.f};
        v4u sq[4], sk[4], sv[2];
#define R_LOAD(tt) do { _Pragma("unroll") for (int i = 0; i < 4; ++i) { const int e = tid + 512 * i, row = e >> 5, p = e & 31; \
            sq[i] = *(const GAS v4u*)(qg + (size_t)(64 * (tt) + row) * 1024 + p * 8); sk[i] = *(const GAS v4u*)(kg + (size_t)(64 * (tt) + row) * 1024 + p * 8); } \
        _Pragma("unroll") for (int i = 0; i < 2; ++i) { const int e = tid + 512 * i, row = e >> 4, p = e & 15; sv[i] = *(const GAS v4u*)(vg + (size_t)(64 * (tt) + row) * 2048 + p * 8); } } while (0)
        R_LOAD(0);
        for (int t = 0; t < 32; ++t) {
            __syncthreads();
#pragma unroll
            for (int i = 0; i < 4; ++i) { const int e = tid + 512 * i, row = e >> 5, p = e & 31;
                *(LAS v4u*)(lds + RQ_OFF + row * RQ_STR + p * 16) = sq[i]; *(LAS v4u*)(lds + RK_OFF + row * RK_STR + p * 16) = sk[i]; }
#pragma unroll
            for (int i = 0; i < 2; ++i) { const int e = tid + 512 * i, row = e >> 4, p = e & 15; *(LAS v4u*)(lds + RV_OFF + row * RV_STR + p * 16) = sv[i]; }
            __syncthreads();
            if (t + 1 < 32) R_LOAD(t + 1);
            { const int ib = wave & 3, jb0 = 2 * (wave >> 2);
              f32x4 s0 = (f32x4){0.f, 0.f, 0.f, 0.f}, s1 = s0;
              const LAS unsigned char* qp = lds + RQ_OFF + (16 * ib + r) * RQ_STR + 16 * g;
              const LAS unsigned char* kp = lds + RK_OFF + (16 * jb0 + r) * RK_STR + 16 * g;
#pragma unroll
              for (int kk = 0; kk < 8; ++kk) { const bf16x8 bq = *(const LAS bf16x8*)(qp + 64 * kk), a0 = *(const LAS bf16x8*)(kp + 64 * kk), a1 = *(const LAS bf16x8*)(kp + 16 * RK_STR + 64 * kk);
                  s0 = MFMA16(a0, bq, s0); s1 = MFMA16(a1, bq, s1); }
              const int iq = 16 * ib + r, j0 = 16 * jb0 + 4 * g;
#pragma unroll
              for (int e = 0; e < 4; ++e) { if (j0 + e > iq) s0[e] = 0.f; if (j0 + 16 + e > iq) s1[e] = 0.f; }
              u32x2_r w0, w1; w0.x = cvt2r(s0[0], s0[1]); w0.y = cvt2r(s0[2], s0[3]); w1.x = cvt2r(s1[0], s1[1]); w1.y = cvt2r(s1[2], s1[3]);
              *(LAS u32x2_r*)(lds + RS_OFF + iq * RS_STR + j0 * 2) = w0; *(LAS u32x2_r*)(lds + RS_OFF + iq * RS_STR + (j0 + 16) * 2) = w1; }
            bf16x8 vf[2];
#pragma unroll
            for (int kk = 0; kk < 2; ++kk) { const LAS unsigned char* vp = lds + RV_OFF + (32 * kk + 4 * g + (r >> 2)) * RV_STR + (16 * wave + 4 * (r & 3)) * 2;
                const s16x4_r lo = tr4(vp), hi = tr4(vp + 16 * RV_STR); vf[kk] = __builtin_shufflevector(lo, hi, 0, 1, 2, 3, 4, 5, 6, 7); }
            if (t > 0 && (t & 1) == 0) {
#pragma unroll
                for (int i = 0; i < 16; ++i) Z[i] = Z[i] * gC; }
            __syncthreads();
            f32x4 oacc[4];
            int o32 = 32; asm volatile("" : "+s"(o32));
#pragma unroll
            for (int nt = 0; nt < 4; ++nt) oacc[nt] = (f32x4){0.f, 0.f, 0.f, 0.f};
#pragma unroll
            for (int kk = 0; kk < 2; ++kk)
#pragma unroll
                for (int nt = 0; nt < 4; ++nt) { const LAS unsigned char* sp = lds + RS_OFF + (16 * nt + r) * RS_STR + (32 * kk + 4 * g) * 2;
                    const s16x4_r lo = *(const LAS s16x4_r*)sp, hi = *(const LAS s16x4_r*)(sp + o32);
                    oacc[nt] = MFMA16(vf[kk], __builtin_shufflevector(lo, hi, 0, 1, 2, 3, 4, 5, 6, 7), oacc[nt]); }
#pragma unroll
            for (int kk = 0; kk < 8; ++kk) { v4u zw; zw.x = cvt2r(Z[2 * kk][0], Z[2 * kk][1]); zw.y = cvt2r(Z[2 * kk][2], Z[2 * kk][3]); zw.z = cvt2r(Z[2 * kk + 1][0], Z[2 * kk + 1][1]); zw.w = cvt2r(Z[2 * kk + 1][2], Z[2 * kk + 1][3]);
                const bf16x8 za = __builtin_bit_cast(bf16x8, zw);
#pragma unroll
                for (int nt = 0; nt < 4; ++nt) { const LAS unsigned char* qp = lds + RQ_OFF + (16 * nt + r) * RQ_STR + (32 * kk + 4 * g) * 2;
                    const s16x4_r lo = *(const LAS s16x4_r*)qp, hi = *(const LAS s16x4_r*)(qp + o32);
                    oacc[nt] = MFMA16(za, __builtin_shufflevector(lo, hi, 0, 1, 2, 3, 4, 5, 6, 7), oacc[nt]); }
                __builtin_amdgcn_sched_barrier(0); }
#pragma unroll
            for (int mt = 0; mt < 16; ++mt)
#pragma unroll
                for (int kk = 0; kk < 2; ++kk) { const LAS unsigned char* kp = lds + RK_OFF + (32 * kk + 4 * g + (r >> 2)) * RK_STR + (16 * mt + 4 * (r & 3)) * 2;
                    const s16x4_r lo = tr4(kp), hi = tr4(kp + 16 * RK_STR);
                    Z[mt] = MFMA16(__builtin_shufflevector(lo, hi, 0, 1, 2, 3, 4, 5, 6, 7), vf[kk], Z[mt]);
                    if (kk == 1 && (mt & 1) == 1) __builtin_amdgcn_sched_barrier(0); }
#pragma unroll
            for (int nt = 0; nt < 4; ++nt) { float s = (oacc[nt][0] + oacc[nt][1]) + (oacc[nt][2] + oacc[nt][3]), q = (oacc[nt][0] * oacc[nt][0] + oacc[nt][1] * oacc[nt][1]) + (oacc[nt][2] * oacc[nt][2] + oacc[nt][3] * oacc[nt][3]);
                s += __shfl_xor(s, 16); s += __shfl_xor(s, 32); q += __shfl_xor(q, 16); q += __shfl_xor(q, 32);
                if (g < 2) atomicAdd(stats + ((size_t)h * 32768 + (size_t)(b * 2048 + 64 * t + 16 * nt + r)) * 2 + g, g ? q : s); }
#pragma unroll
            for (int nt = 0; nt < 4; ++nt) { u32x2_r w; w.x = cvt2r(oacc[nt][0], oacc[nt][1]); w.y = cvt2r(oacc[nt][2], oacc[nt][3]);
                if (STORE || (never && w.x == 0x12345678u)) *(GAS u32x2_r*)(vg + (size_t)(64 * t + 16 * nt + r) * 2048 + 16 * wave + 4 * g) = w; }
        }
#undef R_LOAD
    }
}

#if MK_NAIVE_RET
__device__ __forceinline__ void retention_phase_naive(LAS unsigned char* lds, const bf16* Q, const bf16* Kb, bf16* V, int tid, int lane, int wave, int G) {
    LAS bf16* qs = (LAS bf16*)lds;
    LAS bf16* ks = (LAS bf16*)(lds + 32768);
    LAS bf16* vs = (LAS bf16*)(lds + 65536);
    LAS float* po = (LAS float*)(lds + 81920);
    const int d = tid & 127, qq = tid >> 7;
    for (int un = blockIdx.x; un < 256; un += G) {
        const int sl = un & 3, h = (un >> 2) & 3, b = un >> 4;
        const float gC = expf(128.0f * log1pf(-exp2f(-5.0f - (float)h)));
        float st[64];
#pragma unroll
        for (int i = 0; i < 64; ++i) st[i] = 0.f;
        for (int hc = 0; hc < 2048 / 64; ++hc) {
            const size_t row0 = (size_t)b * 2048 + hc * 64;
            if (hc > 0 && (hc & 1) == 0) {
#pragma unroll
                for (int i = 0; i < 64; ++i) st[i] *= gC; }
            __syncthreads();
            for (int e = tid; e < 2048; e += 512) { const int r = e >> 5, p = e & 31;
                *(LAS v4u*)(qs + r * 256 + p * 8) = *(const GAS v4u*)(Q + (row0 + r) * 1024 + h * 256 + p * 8);
                *(LAS v4u*)(ks + r * 256 + p * 8) = *(const GAS v4u*)(Kb + (row0 + r) * 1024 + h * 256 + p * 8); }
            for (int e = tid; e < 1024; e += 512) { const int r = e >> 4, p = e & 15;
                *(LAS v4u*)(vs + r * 128 + p * 8) = *(const GAS v4u*)(V + (row0 + r) * 2048 + h * 512 + sl * 128 + p * 8); }
            __syncthreads();
            for (int tb = 0; tb < 4; ++tb) {
                for (int tt = 0; tt < 16; ++tt) { const int n = tb * 16 + tt;
                    const float vv = __uint_as_float(((unsigned)vs[n * 128 + d]) << 16);
                    float acc = 0.f;
#pragma unroll
                    for (int i8 = 0; i8 < 8; ++i8) { const v4u kw = *(const LAS v4u*)(ks + n * 256 + qq * 64 + i8 * 8), qw = *(const LAS v4u*)(qs + n * 256 + qq * 64 + i8 * 8);
                        const float kf[8] = {bfl(kw.x), bfh(kw.x), bfl(kw.y), bfh(kw.y), bfl(kw.z), bfh(kw.z), bfl(kw.w), bfh(kw.w)};
                        const float qf[8] = {bfl(qw.x), bfh(qw.x), bfl(qw.y), bfh(qw.y), bfl(qw.z), bfh(qw.z), bfl(qw.w), bfh(qw.w)};
#pragma unroll
                        for (int e = 0; e < 8; ++e) { st[i8 * 8 + e] += kf[e] * vv; acc += qf[e] * st[i8 * 8 + e]; } }
                    po[(tt * 4 + qq) * 128 + d] = acc; }
                __syncthreads();
                for (int e = tid; e < 2048; e += 512) { const int tt = e >> 7, dd = e & 127;
                    const float s = (po[(tt * 4 + 0) * 128 + dd] + po[(tt * 4 + 1) * 128 + dd]) + (po[(tt * 4 + 2) * 128 + dd] + po[(tt * 4 + 3) * 128 + dd]);
                    V[(row0 + tb * 16 + tt) * 2048 + h * 512 + sl * 128 + dd] = (bf16)f2bf(s); }
                __syncthreads();
            }
        }
    }
}
#endif
#include <cstddef>

#ifndef PG8_SP2
#define PG8_SP2 true
#endif
#ifndef PG8_ALIGN
#define PG8_ALIGN true
#endif
#ifndef MK_SEAM78
#define MK_SEAM78 0
#endif
#ifndef MK_OPAQUE_TID
#define MK_OPAQUE_TID 1
#endif
#ifndef MK_NAIVE_RET
#define MK_NAIVE_RET 0
#endif
#ifndef MK_CHECK
#define MK_CHECK 0
#endif
#ifndef MK_N_LAUNCHES
#define MK_N_LAUNCHES 1
#endif
constexpr int NWAVES = 8;
constexpr int BATCH = 16, SEQ = 2048, D = 1024, M = BATCH * SEQ, DFF = 2816, NGU = 2 * DFF, NIN = 10240, RV = 2048, NMOD = 9 * D, CHUNK = 128, CONVW = 31;
constexpr float EPS = 1e-6f;
constexpr int NPHASE = 13;
constexpr int N_LAUNCHES = MK_N_LAUNCHES;
constexpr size_t MiB = 1u << 20;
constexpr size_t WS_CTL = 0, CTL_ZERO_BYTES = 2 * MiB;
constexpr size_t WS_MOD = 1 * MiB;
constexpr size_t WS_RSS2 = 1664 * 1024, WS_RSS3 = 1792 * 1024;
constexpr size_t WS_W = 2 * MiB;
constexpr size_t WE_GU1 = 0, WE_D1 = WE_GU1 + (size_t)D * NGU, WE_IN = WE_D1 + (size_t)DFF * D, WE_RO = WE_IN + (size_t)D * NIN, WE_CO = WE_RO + (size_t)RV * D,
                 WE_OUT = WE_CO + (size_t)D * D, WE_GU2 = WE_OUT + (size_t)D * D, WE_D2 = WE_GU2 + (size_t)D * NGU, WE_END = WE_D2 + (size_t)DFF * D;
static_assert(WS_W + WE_END * 2 <= 63 * MiB, "weights fit [2, 63) MiB");
constexpr size_t WS_XN = 64 * MiB;
constexpr size_t WS_ACT = 128 * MiB;
constexpr size_t WS_Q = 128 * MiB, WS_K = 192 * MiB, WS_V = 256 * MiB, WS_U = 384 * MiB, WS_UC = 448 * MiB;
constexpr size_t WS_G2 = 128 * MiB, WS_T = 384 * MiB, WS_H2 = 448 * MiB, WS_END = 512 * MiB;
static_assert(WS_ACT + (size_t)M * DFF * 2 <= WS_H2, "act and h2 do not overlap");
constexpr size_t DO_H1 = 0, DO_BIAS_IN = 64 * MiB, DO_BIAS_GU = DO_BIAS_IN + (size_t)16 * NIN * 4, DO_STATS = 66 * MiB;
constexpr int CW_BAR = 4096;

constexpr int RING_OFF = 0, RING_BYTES = 131072;
constexpr int LDSCTL_OFF = RING_BYTES, MISC_OFF = LDSCTL_OFF + 320;
constexpr int EC_OFF = 132096, EC_BYTES = 1024 + 6144 * 4;
constexpr int LDS_BYTES = 163840;
static_assert(MISC_OFF + 128 <= EC_OFF && EC_OFF + EC_BYTES <= LDS_BYTES && EC_OFF == (int)pg8::PG8_EC_OFF && MISC_OFF + 64 == (int)pg8::PG8_ECPM_OFF, "LDS map");

struct Args { const float* in[24]; float* out; unsigned char* ws; int ph_lo, ph_hi, li, pad; };

__device__ __forceinline__ int src_col(int mode, int nn) {
    if (mode == 1) { const int blk = nn >> 8, w = nn & 255; return (w < 128) ? (blk * 128 + w) : (DFF + blk * 128 + (w - 128)); }
    if (mode == 2) { if (nn < 4096) return nn; if (nn < 6144) { const int t = nn - 4096, blk = t >> 8, w = t & 255; return (w < 128) ? (6144 + blk * 128 + w) : (7168 + blk * 128 + (w - 128)); } if (nn < 8192) return nn - 2048; return nn; }
    return nn;
}
__device__ __forceinline__ void p0_transpose_item(const float* W, int K, int N, bf16* WT, int mode, LAS float* scr, int item, int lane) {
    const int nblk = N / 32, kb = item / nblk, nb = item % nblk, k0 = 64 * kb, n0 = 32 * nb;
    const int sc = src_col(mode, n0 + (lane & 31));
#pragma unroll 8
    for (int i = 0; i < 32; ++i) { const int kk = 2 * i + (lane >> 5); scr[kk * 33 + (lane & 31)] = W[(size_t)(k0 + kk) * N + sc]; }
    LDS_WAIT(); asm volatile("" ::: "memory");
    const int c = lane & 7;
#pragma unroll
    for (int j = 0; j < 4; ++j) { const int n = (lane >> 3) + 8 * j; const LAS float* s = scr + (8 * c) * 33 + n;
        v4u o; o.x = pk2(s[0 * 33], s[1 * 33]); o.y = pk2(s[2 * 33], s[3 * 33]); o.z = pk2(s[4 * 33], s[5 * 33]); o.w = pk2(s[6 * 33], s[7 * 33]);
        *(GAS v4u*)(WT + (size_t)(n0 + n) * K + k0 + 8 * c) = o; }
    LDS_WAIT(); asm volatile("" ::: "memory");
}

__device__ __forceinline__ void modnorm_rows(const float* h, const float* g, const float* sh, const float* sc, bf16* xn, int row_first, int lane) {
    f32x4 gs[4], sv[4];
#pragma unroll
    for (int j = 0; j < 4; ++j) { const int c = 4 * lane + 256 * j; const f32x4 gg = *(const GAS f32x4*)(g + c), ss = *(const GAS f32x4*)(sc + c); gs[j] = gg * (ss + 1.0f); sv[j] = *(const GAS f32x4*)(sh + c); }
    for (int r = 0; r < 16; ++r) { const size_t row = (size_t)(row_first + r);
        const GAS f32x4* xr = (const GAS f32x4*)(h + row * D) + lane; f32x4 v[4]; float s = 0.f;
#pragma unroll
        for (int j = 0; j < 4; ++j) { v[j] = xr[64 * j]; s += (v[j].x * v[j].x + v[j].y * v[j].y) + (v[j].z * v[j].z + v[j].w * v[j].w); }
        const float rstd = 1.0f / sqrtf(wave_sum(s) * (1.0f / D) + EPS);
        GAS unsigned long long* o8 = (GAS unsigned long long*)(xn + row * D) + lane;
#pragma unroll
        for (int j = 0; j < 4; ++j) { const f32x4 y = v[j] * rstd * gs[j] + sv[j]; o8[64 * j] = (unsigned long long)pk2(y.x, y.y) | ((unsigned long long)pk2(y.z, y.w) << 32); } }
}

__device__ __forceinline__ void bias_columns(LAS unsigned char* lds, const float* modp, const bf16* Wt_in, const bf16* Wt_gu2, float* bias_in, float* bias_gu, int tid, int lane, int wave, int G) {
    LAS float* shl = (LAS float*)lds;
    for (int wg = blockIdx.x; wg < 248; wg += G) {
        const bool second = wg >= 160; const bf16* Wt = second ? Wt_gu2 : Wt_in; const int n0 = second ? (wg - 160) * 64 : wg * 64;
        __syncthreads();
        for (int e = tid; e < 16 * 1024; e += 512) { const int b = e >> 10, k = e & 1023; shl[e] = modp[(size_t)b * NMOD + (second ? 6 : 3) * D + k]; }
        __syncthreads();
#pragma unroll 1
        for (int half = 0; half < 2; ++half) {
            float wf[4][16];
#pragma unroll
            for (int rr = 0; rr < 4; ++rr)
#pragma unroll
                for (int j = 0; j < 2; ++j) { const v4u w = *(const GAS v4u*)(Wt + (size_t)(n0 + wave * 8 + half * 4 + rr) * D + 8 * lane + 512 * j);
                    wf[rr][8 * j + 0] = bfl(w.x); wf[rr][8 * j + 1] = bfh(w.x); wf[rr][8 * j + 2] = bfl(w.y); wf[rr][8 * j + 3] = bfh(w.y); wf[rr][8 * j + 4] = bfl(w.z); wf[rr][8 * j + 5] = bfh(w.z); wf[rr][8 * j + 6] = bfl(w.w); wf[rr][8 * j + 7] = bfh(w.w); }
            float mine[4] = {0.f, 0.f, 0.f, 0.f};
#pragma unroll 1
            for (int b = 0; b < 16; ++b) { float sh[16];
#pragma unroll
                for (int j = 0; j < 2; ++j) { const f32x4 s0 = *(const LAS f32x4*)(shl + b * 1024 + 8 * lane + 512 * j), s1 = *(const LAS f32x4*)(shl + b * 1024 + 8 * lane + 512 * j + 4);
                    sh[8 * j] = s0.x; sh[8 * j + 1] = s0.y; sh[8 * j + 2] = s0.z; sh[8 * j + 3] = s0.w; sh[8 * j + 4] = s1.x; sh[8 * j + 5] = s1.y; sh[8 * j + 6] = s1.z; sh[8 * j + 7] = s1.w; }
#pragma unroll
                for (int rr = 0; rr < 4; ++rr) { float s = 0.f;
#pragma unroll
                    for (int e = 0; e < 16; ++e) s += sh[e] * wf[rr][e];
                    s = wave_sum(s); mine[rr] = (lane == b) ? s : mine[rr]; } }
#pragma unroll
            for (int rr = 0; rr < 4; ++rr) { const int n = n0 + wave * 8 + half * 4 + rr;
                if (lane < 16) { if (second) bias_gu[(size_t)lane * NGU + n] = mine[rr]; else bias_in[(size_t)lane * NIN + n] = mine[rr]; } }
        }
    }
}

template <int OFF> __device__ __forceinline__ const void* karg_ptr() {
#if defined(__HIP_DEVICE_COMPILE__)
    const void* p; auto ka = __builtin_amdgcn_kernarg_segment_ptr();
    asm volatile("s_load_dwordx2 %0, %1, %2\n\ts_waitcnt lgkmcnt(0)" : "=s"(p) : "s"(ka), "i"(OFF) : "memory"); return p;
#else
    return nullptr;
#endif
}
#ifndef MK_LAZYARGS
#define MK_LAZYARGS 1
#endif
#if MK_LAZYARGS
#define AIN(i) ((const float*)karg_ptr<8 * (i)>())
#define AOUT ((float*)karg_ptr<192>())
#define AWS ((unsigned char*)karg_ptr<200>())
#else
#define AIN(i) (args.in[i])
#define AOUT (args.out)
#define AWS (args.ws)
#endif
static_assert(offsetof(Args, out) == 192 && offsetof(Args, ws) == 200 && offsetof(Args, ph_lo) == 208, "Args layout");
__global__ void __launch_bounds__(NWAVES * 64, 2) mk_fwd(Args args) {
    extern __shared__ __attribute__((aligned(16))) unsigned char lds_raw[];
    LAS unsigned char* lds = (LAS unsigned char*)lds_raw;
    volatile LAS unsigned* MISC = (volatile LAS unsigned*)(lds + MISC_OFF);
    const int tid = threadIdx.x, lane = tid & 63, wave = __builtin_amdgcn_readfirstlane(tid >> 6);
    const int G = gridDim.x;
#define KWS (AWS)
#define KCTL ((gu32*)(AWS + WS_CTL))
#define KMOD ((float*)(AWS + WS_MOD))
#define KRSS2 ((float*)(AWS + WS_RSS2))
#define KRSS3 ((float*)(AWS + WS_RSS3))
#define KWB ((bf16*)(AWS + WS_W))
#define KXN ((bf16*)(AWS + WS_XN))
#define KDOB ((unsigned char*)AOUT)
#define KH1 ((bf16*)((unsigned char*)AOUT + DO_H1))
#define KH2 ((bf16*)(AWS + WS_H2))
#define KBIN ((float*)((unsigned char*)AOUT + DO_BIAS_IN))
#define KBGU ((float*)((unsigned char*)AOUT + DO_BIAS_GU))
#define KSTATS ((float*)((unsigned char*)AOUT + DO_STATS))
#define KX (AIN(0))
    for (int u = tid; u < (LDS_BYTES - LDSCTL_OFF) / 4; u += NWAVES * 64) ((LAS unsigned*)(lds + LDSCTL_OFF))[u] = 0u;
    __syncthreads();
    XcdBarrier bar; bar.bar = (unsigned*)(KCTL + CW_BAR); bar.x = 0; bar.st = nullptr;
    if (N_LAUNCHES == 1) bar = xcd_barrier_post((unsigned*)(KCTL + CW_BAR), MISC + 8);
    const int lo = args.ph_lo, hi = args.ph_hi;
#define IN(k) (lo <= (k) && (k) < hi)
#define SEAM(k) do { if (IN(k) && IN((k) + 1)) xcd_barrier(bar); } while (0)
    const int gw = blockIdx.x * NWAVES + wave, NGW = G * NWAVES;

    if (IN(0)) {
        LAS float* scr = (LAS float*)(lds + RING_OFF + wave * 16384);
        constexpr int I_GU = (D / 64) * (NGU / 32), I_D = (DFF / 64) * (D / 32), I_IN = (D / 64) * (NIN / 32), I_RO = (RV / 64) * (D / 32), I_SQ = (D / 64) * (D / 32);
        constexpr int NITEMS = 2 * I_GU + 2 * I_D + I_IN + I_RO + 2 * I_SQ;
        for (int it = gw; it < NITEMS; it += NGW) {
            int r = it;
            if (r < I_GU) { p0_transpose_item(AIN(6), D, NGU, KWB + WE_GU1, 1, scr, r, lane); continue; } r -= I_GU;
            if (r < I_D)  { p0_transpose_item(AIN(7), DFF, D, KWB + WE_D1, 0, scr, r, lane); continue; } r -= I_D;
            if (r < I_IN) { p0_transpose_item(AIN(9), D, NIN, KWB + WE_IN, 2, scr, r, lane); continue; } r -= I_IN;
            if (r < I_RO) { p0_transpose_item(AIN(12), RV, D, KWB + WE_RO, 0, scr, r, lane); continue; } r -= I_RO;
            if (r < I_SQ) { p0_transpose_item(AIN(17), D, D, KWB + WE_CO, 0, scr, r, lane); continue; } r -= I_SQ;
            if (r < I_SQ) { p0_transpose_item(AIN(19), D, D, KWB + WE_OUT, 0, scr, r, lane); continue; } r -= I_SQ;
            if (r < I_GU) { p0_transpose_item(AIN(21), D, NGU, KWB + WE_GU2, 1, scr, r, lane); continue; } r -= I_GU;
            p0_transpose_item(AIN(22), DFF, D, KWB + WE_D2, 0, scr, r, lane);
        }
        __syncthreads();
        LAS float* sc_l = (LAS float*)(lds + RING_OFF);
        const float* cin = AIN(1); const float* wmod = AIN(3); const float* bmod = AIN(4);
        for (int it = blockIdx.x; it < 18 * 16; it += G) {
            const int cb = it % 18, ks = it / 18, n = cb * 512 + tid, k0 = ks * 64;
            for (int e = tid; e < 16 * 64; e += NWAVES * 64) { const float cv = cin[(e >> 6) * D + k0 + (e & 63)]; sc_l[e] = cv / (1.0f + expf(-cv)); }
            __syncthreads();
            float a[16];
#pragma unroll
            for (int b = 0; b < 16; ++b) a[b] = (ks == 0) ? bmod[n] : 0.f;
            for (int k = 0; k < 64; ++k) { const float w = wmod[(size_t)(k0 + k) * NMOD + n];
#pragma unroll
                for (int b = 0; b < 16; ++b) a[b] += sc_l[b * 64 + k] * w; }
#pragma unroll
            for (int b = 0; b < 16; ++b) atomicAdd(KMOD + (size_t)b * NMOD + n, a[b]);
            __syncthreads();
        }
    }
    SEAM(0);
    if (IN(1)) {
        for (int r0 = gw * 16; r0 < M; r0 += NGW * 16) { const int b = r0 / SEQ; modnorm_rows(KX, AIN(5), KMOD + (size_t)b * NMOD + 0 * D, KMOD + (size_t)b * NMOD + 1 * D, KXN, r0, lane); }
        for (size_t e = (size_t)blockIdx.x * 512 + tid; e < (size_t)M * 8 / 4; e += (size_t)G * 512) ((GAS f32x4*)KSTATS)[e] = (f32x4){0.f, 0.f, 0.f, 0.f};
        bias_columns(lds + RING_OFF, KMOD, KWB + WE_IN, KWB + WE_GU2, KBIN, KBGU, tid, lane, wave, G);
    }
    SEAM(1);
    if (IN(2)) { pg8::Gemm g{KXN, KWB + WE_GU1, M, NGU, D}; pg8::StaticOrder S; S.init(M, NGU, G, (int)blockIdx.x);
        pg8::EpiSwiGLU<false> E{(bf16*)(KWS + WS_ACT), DFF, pg8::EpiCache{}};
        pg8::gemm_phase<pg8::EpiSwiGLU<false>, pg8::StaticOrder, PG8_ALIGN, PG8_SP2>(lds + RING_OFF, g, S, E); }
    SEAM(2);
    if (IN(3)) { pg8::Gemm g{(const bf16*)(KWS + WS_ACT), KWB + WE_D1, M, D, DFF}; pg8::StaticOrder S; S.init(M, D, G, (int)blockIdx.x);
        pg8::EpiResNorm<false> E{KX, KH1, KXN, KRSS2, KMOD + 2 * D, AIN(8), KMOD + 4 * D, NMOD, 0.5f};
        pg8::gemm_phase<pg8::EpiResNorm<false>, pg8::StaticOrder, PG8_ALIGN, PG8_SP2>(lds + RING_OFF, g, S, E); }
    SEAM(3);
    if (IN(4)) { if (tid == 0) MISC[16] = 0xffffffffu; pg8::Gemm g{KXN, KWB + WE_IN, M, 6144, D}; pg8::StaticOrder S; S.init(M, 6144, G, (int)blockIdx.x);
        pg8::EpiQKVU E{(bf16*)(KWS + WS_Q), (bf16*)(KWS + WS_K), (bf16*)(KWS + WS_V), (bf16*)(KWS + WS_U), (const int*)AIN(2), pg8::EpiCache{KRSS2, KBIN, NIN, 6144}};
        pg8::gemm_phase<pg8::EpiQKVU, pg8::StaticOrder, PG8_ALIGN, PG8_SP2>(lds + RING_OFF, g, S, E); }
    SEAM(4);
    if (IN(5)) { conv_phase(lds + RING_OFF, (const bf16*)(KWS + WS_U), AIN(13), AIN(14), AIN(15), AIN(16), (bf16*)(KWS + WS_UC), tid, lane, wave, G);
        retention_phase(lds + RING_OFF, (const bf16*)(KWS + WS_Q), (const bf16*)(KWS + WS_K), (bf16*)(KWS + WS_V), KSTATS, tid, lane, wave, G); }
    SEAM(5);
    if (IN(6)) { if (tid == 0) MISC[16] = 0xffffffffu; pg8::Gemm g{KXN, KWB + WE_IN + (size_t)6144 * D, M, 4096, D}; pg8::StaticOrder S; S.init(M, 4096, G, (int)blockIdx.x);
        pg8::EpiYG E{(bf16*)(KWS + WS_V), (bf16*)(KWS + WS_G2), KSTATS, AIN(10), AIN(11), pg8::EpiCache{KRSS2, KBIN + 6144, NIN, 4096}};
        pg8::gemm_phase<pg8::EpiYG, pg8::StaticOrder, PG8_ALIGN, PG8_SP2>(lds + RING_OFF, g, S, E); }
    SEAM(6);
    if (IN(7)) { pg8::Gemm g{(const bf16*)(KWS + WS_UC), KWB + WE_CO, M, D, D}; pg8::StaticOrder S; S.init(M, D, G, (int)blockIdx.x);
        pg8::EpiConvO E{(bf16*)(KWS + WS_T), (const bf16*)(KWS + WS_G2), AIN(18)};
        pg8::gemm_phase<pg8::EpiConvO, pg8::StaticOrder, PG8_ALIGN, PG8_SP2>(lds + RING_OFF, g, S, E); }
#if MK_SEAM78
    SEAM(7);
#endif
    if (IN(8)) { pg8::Gemm g{(const bf16*)(KWS + WS_V), KWB + WE_RO, M, D, RV}; pg8::StaticOrder S; S.init(M, D, G, (int)blockIdx.x);
        pg8::EpiRetO E{(bf16*)(KWS + WS_T), (const bf16*)(KWS + WS_G2)};
        pg8::gemm_phase<pg8::EpiRetO, pg8::StaticOrder, PG8_ALIGN, PG8_SP2>(lds + RING_OFF, g, S, E); }
    SEAM(8);
    if (IN(9)) { pg8::Gemm g{(const bf16*)(KWS + WS_T), KWB + WE_OUT, M, D, D}; pg8::StaticOrder S; S.init(M, D, G, (int)blockIdx.x);
        pg8::EpiResNorm<true> E{KH1, KH2, KXN, KRSS3, KMOD + 5 * D, AIN(20), KMOD + 7 * D, NMOD, 1.0f};
        pg8::gemm_phase<pg8::EpiResNorm<true>, pg8::StaticOrder, PG8_ALIGN, PG8_SP2>(lds + RING_OFF, g, S, E); }
    SEAM(9);
    if (IN(10)) { if (tid == 0) MISC[16] = 0xffffffffu; pg8::Gemm g{KXN, KWB + WE_GU2, M, NGU, D}; pg8::StaticOrder S; S.init(M, NGU, G, (int)blockIdx.x);
        pg8::EpiSwiGLU<true> E{(bf16*)(KWS + WS_ACT), DFF, pg8::EpiCache{KRSS3, KBGU, NGU, NGU}};
        pg8::gemm_phase<pg8::EpiSwiGLU<true>, pg8::StaticOrder, PG8_ALIGN, PG8_SP2>(lds + RING_OFF, g, S, E); }
    SEAM(10);
    if (IN(11)) { pg8::Gemm g{(const bf16*)(KWS + WS_ACT), KWB + WE_D2, M, D, DFF}; pg8::StaticOrder S; S.init(M, D, G, (int)blockIdx.x);
        pg8::EpiResidOut E{KH2, AOUT, KMOD + 8 * D, NMOD, 0.5f};
        pg8::gemm_phase<pg8::EpiResidOut, pg8::StaticOrder, PG8_ALIGN, PG8_SP2>(lds + RING_OFF, g, S, E); }
    SEAM(11);
    if (IN(12)) { float* hbuf = AOUT; for (int r0 = gw * 16; r0 < M; r0 += NGW * 16) {
        const float* gf = AIN(23); f32x4 gs[4];
#pragma unroll
        for (int j = 0; j < 4; ++j) gs[j] = *(const GAS f32x4*)(gf + 4 * lane + 256 * j);
        for (int r = 0; r < 16; ++r) { GAS f32x4* xr = (GAS f32x4*)(hbuf + (size_t)(r0 + r) * D) + lane; f32x4 v[4]; float s = 0.f;
#pragma unroll
            for (int j = 0; j < 4; ++j) { v[j] = xr[64 * j]; s += (v[j].x * v[j].x + v[j].y * v[j].y) + (v[j].z * v[j].z + v[j].w * v[j].w); }
            const float rstd = 1.0f / sqrtf(wave_sum(s) * (1.0f / D) + EPS);
#pragma unroll
            for (int j = 0; j < 4; ++j) xr[64 * j] = v[j] * rstd * gs[j]; } } }
#undef IN
#undef SEAM
#undef KWS
#undef KCTL
#undef KMOD
#undef KRSS2
#undef KRSS3
#undef KWB
#undef KXN
#undef KDOB
#undef KH1
#undef KH2
#undef KBIN
#undef KBGU
#undef KSTATS
#undef KX
}


#if MK_CHECK
constexpr int NSAMP = 64;
constexpr size_t WS_CHK = 63 * MiB;
__device__ __forceinline__ int srow(int i) { switch (i) { case 0: return 0; case 1: return 1; case 2: return 29; case 3: return 30; case 4: return 31; case 5: return 127; case 6: return 128; case 7: return 255; case 8: return 2047; case 9: return 2048; case 10: return 2049; case 11: return 2078; case 12: return 4095; case 13: return 16384; case 14: return 32640; case 15: return 32767; default: return (i * 509 + 12345) & 32767; } }
__device__ __forceinline__ float b2f(bf16 v) { return __uint_as_float(((unsigned)v) << 16); }
__device__ __forceinline__ void upd(unsigned* res, int s, float err) { if (!(err == err)) err = 1e30f; atomicMax(res + s, __float_as_uint(err)); }
__device__ __forceinline__ float nerr(float got, float exp, float ta, float tr) { return fabsf(got - exp) / (ta + tr * fabsf(exp)); }
__device__ __forceinline__ float block_sum(float v, float* red) {
    v = wave_sum(v); __syncthreads(); if ((threadIdx.x & 63) == 0) red[threadIdx.x >> 6] = v; __syncthreads(); const float r = (red[0] + red[1]) + (red[2] + red[3]); __syncthreads(); return r; }
__device__ __forceinline__ float dsilu(float x) { return x / (1.0f + expf(-x)); }
__device__ __forceinline__ float dsig(float x) { return 1.0f / (1.0f + expf(-x)); }

__device__ __forceinline__ void true_xn(const bf16* Hrow, const float* g, const float* sh, const float* sc, float* arow, float* red, int tid) {
    float s = 0.f; for (int k = tid; k < D; k += 256) { const float v = b2f(Hrow[k]); arow[k] = v; s += v * v; }
    const float rstd = 1.0f / sqrtf(block_sum(s, red) / D + EPS);
    for (int k = tid; k < D; k += 256) arow[k] = arow[k] * rstd * g[k] * (1.0f + sc[k]) + sh[k];
    __syncthreads();
}
__global__ void __launch_bounds__(256) k_check(Args args, int stage, int mode) {
    __shared__ float arow[2816]; __shared__ float red[4]; __shared__ float sc_s[2048];
    const int i = blockIdx.x, r = srow(i), b = r / SEQ, tid = threadIdx.x;
    unsigned char* ws = args.ws; unsigned* res = (unsigned*)(ws + WS_CTL) + 8192;
    const float* modp = (const float*)(ws + WS_MOD) + (size_t)b * NMOD; const bf16* XN = (const bf16*)(ws + WS_XN);
    unsigned char* dob = (unsigned char*)args.out; const bf16* H1 = (const bf16*)(dob + DO_H1); const bf16* H2 = (const bf16*)(ws + WS_H2);
    float* EXP = (float*)(ws + WS_CHK) + (size_t)i * 2048;
    if (stage == 0) {
        const int bb = i & 15; const float* cin = args.in[1];
        for (int k = tid; k < D; k += 256) arow[k] = dsilu(cin[bb * D + k]);
        __syncthreads();
        const int n = tid * 36 + (i >> 4) * 9; float a = args.in[4][n];
        for (int k = 0; k < D; ++k) a += arow[k] * args.in[3][(size_t)k * NMOD + n];
        upd(res, 0, nerr(((const float*)(ws + WS_MOD))[(size_t)bb * NMOD + n], a, 2e-3f, 2e-3f));
        return;
    }
    if (stage == 1) {
        const float* src = args.in[0]; const float* g = args.in[5]; float s = 0.f;
        for (int k = tid; k < D; k += 256) { const float v = src[(size_t)r * D + k]; arow[k] = v; s += v * v; }
        const float rstd = 1.0f / sqrtf(block_sum(s, red) / D + EPS);
        for (int k = tid; k < D; k += 256) { const float e = arow[k] * rstd * g[k] * (1.0f + modp[1 * D + k]) + modp[0 * D + k]; upd(res, 1, nerr(b2f(XN[(size_t)r * D + k]), e, 0.02f, 0.01f)); }
        const float* bias_in = (const float*)(dob + DO_BIAS_IN); const float* bias_gu = (const float*)(dob + DO_BIAS_GU); const int bb = i & 15;
        const float* mb = (const float*)(ws + WS_MOD) + (size_t)bb * NMOD;
        { const int n = tid * 40 + (i >> 4) * 7; float a = 0.f; const int col = src_col(2, n); for (int k = 0; k < D; ++k) a += mb[3 * D + k] * args.in[9][(size_t)k * NIN + col]; upd(res, 1, nerr(bias_in[(size_t)bb * NIN + n], a, 2e-3f, 2e-3f)); }
        { const int n = tid * 22 + (i >> 4) * 5; float a = 0.f; const int col = src_col(1, n); for (int k = 0; k < D; ++k) a += mb[6 * D + k] * args.in[21][(size_t)k * NGU + col]; upd(res, 1, nerr(bias_gu[(size_t)bb * NGU + n], a, 2e-3f, 2e-3f)); }
        return;
    }
    if (stage == 2 || stage == 10) {
        const float* w = args.in[stage == 2 ? 6 : 21]; const bf16* act = (const bf16*)(ws + WS_ACT);
        if (stage == 2) { for (int k = tid; k < D; k += 256) arow[k] = b2f(XN[(size_t)r * D + k]); __syncthreads(); }
        else true_xn(H2 + (size_t)r * D, args.in[20], modp + 6 * D, modp + 7 * D, arow, red, tid);
        for (int c = tid; c < DFF; c += 256) { float gsum = 0.f, usum = 0.f; for (int k = 0; k < D; ++k) { gsum += arow[k] * w[(size_t)k * NGU + c]; usum += arow[k] * w[(size_t)k * NGU + DFF + c]; }
            upd(res, stage, nerr(b2f(act[(size_t)r * DFF + c]), dsilu(gsum) * usum, 0.04f, 0.03f)); }
        return;
    }
    if (stage == 3 || stage == 9) {
        const bf16* Hout = stage == 3 ? H1 : H2; const float* rss = (const float*)(ws + (stage == 3 ? WS_RSS2 : WS_RSS3));
        const float* gt = modp + (stage == 3 ? 2 : 5) * D; const float* g = args.in[stage == 3 ? 8 : 20]; const float* sc = modp + (stage == 3 ? 4 : 7) * D; const float scale = stage == 3 ? 0.5f : 1.0f;
        const int K = stage == 3 ? DFF : D; const bf16* A = (const bf16*)(ws + (stage == 3 ? WS_ACT : WS_T)); const float* w = args.in[stage == 3 ? 7 : 19];
        for (int k = tid; k < K; k += 256) arow[k] = b2f(A[(size_t)r * K + k]);
        __syncthreads();
        float ssum = 0.f;
        for (int c = tid; c < D; c += 256) { float s = 0.f; for (int k = 0; k < K; ++k) s += arow[k] * w[(size_t)k * D + c];
            const float base = stage == 3 ? args.in[0][(size_t)r * D + c] : b2f(H1[(size_t)r * D + c]); const float e = base + scale * gt[c] * s; ssum += e * e;
            upd(res, stage, nerr(b2f(Hout[(size_t)r * D + c]), e, 0.03f, 0.01f)); upd(res, stage, nerr(b2f(XN[(size_t)r * D + c]), e * g[c] * (1.0f + sc[c]), 0.03f, 0.012f)); }
        ssum = block_sum(ssum, red); if (tid == 0) upd(res, stage, nerr(rss[r], ssum, 1.0f, 0.01f));
        return;
    }
    if (stage == 4) {
        const float* w = args.in[9]; const bf16* Qb = (const bf16*)(ws + WS_Q); const bf16* Kb = (const bf16*)(ws + WS_K); const bf16* Vb = (const bf16*)(ws + WS_V); const bf16* U = (const bf16*)(ws + WS_U);
        true_xn(H1 + (size_t)r * D, args.in[8], modp + 3 * D, modp + 4 * D, arow, red, tid);
        const float p = (float)((const int*)args.in[2])[r]; const int sl = r & 127;
        for (int c = tid; c < 2048; c += 256) {
            const int isk = c >= 1024, cc = c & 1023, h = cc >> 8, j = cc & 255, fi = j & 127, c1 = (isk ? 1024 : 0) + h * 256 + fi, c2 = c1 + 128;
            float x1 = 0.f, x2 = 0.f; for (int k = 0; k < D; ++k) { x1 += arow[k] * w[(size_t)k * NIN + c1]; x2 += arow[k] * w[(size_t)k * NIN + c2]; }
            const float fr = powf(10000.0f, -(float)fi * (2.0f / 256.0f)), ang = p * fr; float sn, cs; sincosf(ang, &sn, &cs);
            float o = (j < 128) ? (x1 * cs - x2 * sn) : (x1 * sn + x2 * cs);
            const float gam = 1.0f - exp2f(-5.0f - (float)h); const float dsc = isk ? powf(gam, -(float)sl) * 0.0625f : powf(gam, (float)sl);
            upd(res, 4, nerr(b2f((isk ? Kb : Qb)[(size_t)r * 1024 + cc]), o * dsc, 0.03f * dsc + 1e-5f, 0.03f)); }
        for (int c = tid; c < 2048; c += 256) { float a = 0.f; for (int k = 0; k < D; ++k) a += arow[k] * w[(size_t)k * NIN + 2048 + c]; upd(res, 4, nerr(b2f(Vb[(size_t)r * 2048 + c]), a, 0.03f, 0.02f)); }
        for (int c = tid; c < D; c += 256) { float a = 0.f, bb = 0.f; for (int k = 0; k < D; ++k) { a += arow[k] * w[(size_t)k * NIN + 6144 + c]; bb += arow[k] * w[(size_t)k * NIN + 7168 + c]; }
            upd(res, 4, nerr(b2f(U[(size_t)r * D + c]), a * dsig(bb), 0.03f, 0.02f)); }
        return;
    }
    if (stage == 5) {
        const bf16* Qb = (const bf16*)(ws + WS_Q); const bf16* Kb = (const bf16*)(ws + WS_K); const bf16* Vb = (const bf16*)(ws + WS_V); const int s = r % SEQ, rb = r - s;
        if (mode == 1) {
            for (int h = 0; h < 4; ++h) { const float gam = 1.0f - exp2f(-5.0f - (float)h), gC = powf(gam, 128.0f);
                __syncthreads();
                for (int k = tid; k < 256; k += 256) arow[k] = b2f(Qb[(size_t)r * 1024 + h * 256 + k]);
                __syncthreads();
                for (int m = tid; m <= s; m += 256) { float d = 0.f; for (int k = 0; k < 256; ++k) d += arow[k] * b2f(Kb[(size_t)(rb + m) * 1024 + h * 256 + k]); sc_s[m] = d * powf(gC, (float)((s >> 7) - (m >> 7))); }
                __syncthreads();
                for (int dcol = tid; dcol < 512; dcol += 256) { float a = 0.f; for (int m = 0; m <= s; ++m) a += sc_s[m] * b2f(Vb[(size_t)(rb + m) * 2048 + h * 512 + dcol]); EXP[h * 512 + dcol] = a; } }
        } else {
            const float* st = (const float*)(dob + DO_STATS);
            for (int h = 0; h < 4; ++h) { float num = 0.f, den = 0.f, es = 0.f; for (int dcol = tid; dcol < 512; dcol += 256) { const float e = EXP[h * 512 + dcol], g = b2f(Vb[(size_t)r * 2048 + h * 512 + dcol]); num += (g - e) * (g - e); den += e * e; es += e; }
                num = block_sum(num, red); den = block_sum(den, red); es = block_sum(es, red);
                if (tid == 0) { upd(res, 5, sqrtf(num / (den + 1e-20f)) / 0.03f); const float rms = sqrtf(den / 512.0f) + 1e-20f;
                    upd(res, 5, fabsf(st[((size_t)h * 32768 + r) * 2] - es) / (0.03f * 512.0f * rms)); upd(res, 5, nerr(st[((size_t)h * 32768 + r) * 2 + 1], den, 1e-12f, 0.03f)); } }
            const bf16* U = (const bf16*)(ws + WS_U); const bf16* UC = (const bf16*)(ws + WS_UC); float cv[4]; float sum = 0.f;
            for (int q = 0; q < 4; ++q) { const int c = tid + 256 * q; float a = args.in[14][c];
                for (int t = 0; t < 31; ++t) { const int ss = s + t - 30; if (ss >= 0) a += args.in[13][t * D + c] * b2f(U[(size_t)(r + t - 30) * D + c]); }
                cv[q] = a; sum += a; }
            const float mean = block_sum(sum, red) / D; float q2 = 0.f;
            for (int q = 0; q < 4; ++q) q2 += (cv[q] - mean) * (cv[q] - mean);
            const float rstd = 1.0f / sqrtf(block_sum(q2, red) / D + EPS);
            for (int q = 0; q < 4; ++q) { const int c = tid + 256 * q; const float y = (cv[q] - mean) * rstd * args.in[15][c] + args.in[16][c]; upd(res, 5, nerr(b2f(UC[(size_t)r * D + c]), dsilu(y), 0.03f, 0.02f)); }
        }
        return;
    }
    if (stage == 6) {
        const float* w = args.in[9]; bf16* OY = (bf16*)(ws + WS_V); const bf16* G2 = (const bf16*)(ws + WS_G2);
        true_xn(H1 + (size_t)r * D, args.in[8], modp + 3 * D, modp + 4 * D, arow, red, tid);
        if (mode == 1) { for (int h = 0; h < 4; ++h) { float v0 = b2f(OY[(size_t)r * 2048 + h * 512 + tid]), v1 = b2f(OY[(size_t)r * 2048 + h * 512 + 256 + tid]);
                const float mean = block_sum(v0 + v1, red) / 512.0f; const float var = block_sum((v0 - mean) * (v0 - mean) + (v1 - mean) * (v1 - mean), red) / 512.0f; const float rstd = 1.0f / sqrtf(var + EPS);
                for (int q = 0; q < 2; ++q) { const int c = h * 512 + q * 256 + tid; float a = 0.f; for (int k = 0; k < D; ++k) a += arow[k] * w[(size_t)k * NIN + 4096 + c];
                    EXP[c] = (((q ? v1 : v0) - mean) * rstd * args.in[10][c] + args.in[11][c]) * dsilu(a); } } }
        else { for (int c = tid; c < 2048; c += 256) upd(res, 6, nerr(b2f(OY[(size_t)r * 2048 + c]), EXP[c], 0.04f, 0.03f));
            for (int c = tid; c < 2048; c += 256) { float a = 0.f; for (int k = 0; k < D; ++k) a += arow[k] * w[(size_t)k * NIN + 8192 + c]; upd(res, 6, nerr(b2f(G2[(size_t)r * 2048 + c]), dsig(a), 0.03f, 0.02f)); } }
        return;
    }
    if (stage == 7) {
        const bf16* UC = (const bf16*)(ws + WS_UC); const bf16* G2 = (const bf16*)(ws + WS_G2); const bf16* T = (const bf16*)(ws + WS_T);
        for (int k = tid; k < D; k += 256) arow[k] = b2f(UC[(size_t)r * D + k]);
        __syncthreads();
        for (int c = tid; c < D; c += 256) { float a = args.in[18][c]; for (int k = 0; k < D; ++k) a += arow[k] * args.in[17][(size_t)k * D + c];
            upd(res, 7, nerr(b2f(T[(size_t)r * D + c]), a * b2f(G2[(size_t)r * 2048 + 1024 + c]), 0.03f, 0.02f)); }
        return;
    }
    if (stage == 8) {
        const bf16* Y = (const bf16*)(ws + WS_V); const bf16* G2 = (const bf16*)(ws + WS_G2); const bf16* T = (const bf16*)(ws + WS_T);
        if (mode == 1) { for (int k = tid; k < 2048; k += 256) sc_s[k] = b2f(Y[(size_t)r * 2048 + k]);
            __syncthreads();
            for (int c = tid; c < D; c += 256) { float a = 0.f; for (int k = 0; k < 2048; ++k) a += sc_s[k] * args.in[12][(size_t)k * D + c]; EXP[c] = b2f(T[(size_t)r * D + c]) + b2f(G2[(size_t)r * 2048 + c]) * a; } }
        else { for (int c = tid; c < D; c += 256) upd(res, 8, nerr(b2f(T[(size_t)r * D + c]), EXP[c], 0.03f, 0.02f)); }
        return;
    }
    if (stage == 11) {
        const float* w = args.in[22]; const bf16* act = (const bf16*)(ws + WS_ACT); const float* gt = modp + 8 * D;
        for (int k = tid; k < DFF; k += 256) arow[k] = b2f(act[(size_t)r * DFF + k]);
        __syncthreads();
        for (int c = tid; c < D; c += 256) { float s = 0.f; for (int k = 0; k < DFF; ++k) s += arow[k] * w[(size_t)k * D + c];
            upd(res, 11, nerr(args.out[(size_t)r * D + c], b2f(H2[(size_t)r * D + c]) + 0.5f * gt[c] * s, 0.02f, 0.01f)); }
        return;
    }
    if (stage == 12) {
        float* hbuf = args.out;
        if (mode == 1) { float s = 0.f; for (int k = tid; k < D; k += 256) { const float v = hbuf[(size_t)r * D + k]; arow[k] = v; s += v * v; }
            const float rstd = 1.0f / sqrtf(block_sum(s, red) / D + EPS);
            for (int k = tid; k < D; k += 256) EXP[k] = arow[k] * rstd * args.in[23][k]; }
        else { for (int c = tid; c < D; c += 256) upd(res, 12, nerr(hbuf[(size_t)r * D + c], EXP[c], 1e-3f, 1e-3f)); }
        return;
    }
}
__global__ void k_apply(Args args) {
    const unsigned* res = (const unsigned*)(args.ws + WS_CTL) + 8192; int bad = -1;
    for (int s = 0; s < NPHASE; ++s) if (__uint_as_float(res[s]) > 1.0f) { bad = s; break; }
    if (bad < 0) return;
    const float c = 1.0f + 2.0f * powf(1.25f, (float)bad);
    for (size_t e = (size_t)blockIdx.x * blockDim.x + threadIdx.x; e < (size_t)M * D; e += (size_t)gridDim.x * blockDim.x) args.out[e] *= c;
}
#endif

extern "C" void kernel_launch(void* const* d_in, const int* in_sizes, int n_in, void* d_out, int out_size, void* d_ws, size_t ws_size, hipStream_t stream) {
    static int grid = 0;
    if (grid == 0) {
        if (n_in != 24 || in_sizes[0] != M * D || out_size != M * D || ws_size < WS_END) { fprintf(stderr, "kernel_launch: unexpected shapes (n_in %d, in0 %d, out %d, ws %zu); nothing launched\n", n_in, n_in > 0 ? in_sizes[0] : -1, out_size, ws_size); grid = -1; return; }
        int dev = 0, cus = 0, per_cu = 0;
        if (hipGetDevice(&dev) != hipSuccess || hipDeviceGetAttribute(&cus, hipDeviceAttributeMultiprocessorCount, dev) != hipSuccess) { grid = -1; return; }
        if (hipFuncSetAttribute((const void*)mk_fwd, hipFuncAttributeMaxDynamicSharedMemorySize, LDS_BYTES) != hipSuccess) { fprintf(stderr, "kernel_launch: hipFuncSetAttribute failed\n"); grid = -1; return; }
        if (hipOccupancyMaxActiveBlocksPerMultiprocessor(&per_cu, (const void*)mk_fwd, NWAVES * 64, LDS_BYTES) != hipSuccess || per_cu < 1)
            fprintf(stderr, "kernel_launch: note: occupancy query reports %d workgroups per CU\n", per_cu);
        (void)hipGetLastError();
        grid = cus;
    }
    if (grid < 0) return;
    if (hipMemsetAsync((char*)d_ws + WS_CTL, 0, CTL_ZERO_BYTES, stream) != hipSuccess) return;
    Args a{};
    for (int i = 0; i < 24; ++i) a.in[i] = (const float*)d_in[i];
    a.out = (float*)d_out; a.ws = (unsigned char*)d_ws;
    for (int li = 0; li < N_LAUNCHES; ++li) {
        a.ph_lo = (N_LAUNCHES == 1) ? 0 : li; a.ph_hi = (N_LAUNCHES == 1) ? NPHASE : li + 1; a.li = li; a.pad = 0;
#if MK_CHECK
        if (li == 5 || li == 6 || li == 8 || li == 12) hipLaunchKernelGGL(k_check, dim3(NSAMP), dim3(256), 0, stream, a, li, 1);
#endif
        hipLaunchKernelGGL(mk_fwd, dim3(grid), dim3(NWAVES * 64), LDS_BYTES, stream, a);
#if MK_CHECK
        hipLaunchKernelGGL(k_check, dim3(NSAMP), dim3(256), 0, stream, a, li, 0);
#endif
    }
#if MK_CHECK
    hipLaunchKernelGGL(k_apply, dim3(1024), dim3(256), 0, stream, a);
#endif
}
```
